# Optimizing an MI355X kernel written in HIP

```python
import math
import jax, jax.numpy as jnp
from jax import lax
import numpy as np

D_MODEL = 1024
BATCH = 8
SEQ = 4096
DEPTH = 1

N_HEADS = 8
HEAD_DIM = 64
N_KV = 2
GQA = N_HEADS // N_KV
CMP_BLOCK = 32
CMP_STRIDE = 16
SLC_BLOCK = 64
N_SLC = 16
WINDOW = 512
Q_BLOCK = 128
SLC_Q_BLOCK = 64
FORCE_SCORE = 1e4
SCALE = 1.0 / math.sqrt(HEAD_DIM)
CONV_WIDTH = D_MODEL
CONV_K = 3
D_FF = 4 * D_MODEL
EPS = 1e-6
NEG_INF = -1e30

QW = N_HEADS * HEAD_DIM
KVW = N_KV * HEAD_DIM
SPLITS = (QW, KVW, KVW, KVW, KVW, KVW, KVW, 3 * N_HEADS,
          CONV_WIDTH, CONV_WIDTH, CONV_WIDTH, D_MODEL, D_MODEL)
PROJ_WIDTH = sum(SPLITS)
SPLIT_POINTS = tuple(int(v) for v in np.cumsum(SPLITS)[:-1])

kernel_name = "hybrid_nsa_shortconv_gated_block"


def rms_norm(x, g):
    xf = x.astype(jnp.float32)
    y = xf * lax.rsqrt(jnp.mean(xf * xf, axis=-1, keepdims=True) + EPS)
    return (y * g.astype(jnp.float32)).astype(x.dtype)


def alibi_slopes():
    s = 2.0 ** (-8.0 * jnp.arange(1, N_HEADS + 1, dtype=jnp.float32) / N_HEADS)
    return s.reshape(N_KV, GQA)


def masked_softmax(s, mask):
    s = jnp.where(mask, s.astype(jnp.float32), NEG_INF)
    m = jnp.max(s, axis=-1, keepdims=True)
    e = jnp.where(mask, jnp.exp(s - m), 0.0)
    return e / jnp.maximum(jnp.sum(e, axis=-1, keepdims=True), 1e-30)


def compress(k, pos_emb, w):
    B_, S_ = k.shape[0], k.shape[1]
    r = CMP_BLOCK // CMP_STRIDE
    c = k.reshape(B_, S_ // CMP_STRIDE, CMP_STRIDE, N_KV, HEAD_DIM)
    nc = S_ // CMP_STRIDE - r + 1
    blocks = jnp.concatenate([c[:, i:i + nc] for i in range(r)], axis=2)
    blocks = blocks + pos_emb[None, None, :, None, :]
    blocks = blocks.transpose(0, 1, 3, 2, 4).reshape(B_, nc, N_KV, CMP_BLOCK * HEAD_DIM)
    return blocks @ w


def hybrid_layer(x, norm1_g, w_in, q_norm_g, k_norm_g, cmp_pos_k, cmp_pos_v,
                 w_cmp_k, w_cmp_v, conv_w, w_branch_a, w_branch_b, w_out,
                 norm2_g, w_up, w_down):
    B_, S_, _ = x.shape
    xn = rms_norm(x, norm1_g)
    proj = xn @ w_in
    (q, k_c, v_c, k_s, v_s, k_w, v_w, g_nsa, conv_b, conv_c, conv_x,
     gate_a, gate_b) = jnp.split(proj, SPLIT_POINTS, axis=-1)

    q = rms_norm(q.reshape(B_, S_, N_HEADS, HEAD_DIM), q_norm_g)
    q = q.reshape(B_, S_, N_KV, GQA, HEAD_DIM)
    kv_shape = (B_, S_, N_KV, HEAD_DIM)
    k_s = rms_norm(k_s.reshape(kv_shape), k_norm_g[1])
    k_w = rms_norm(k_w.reshape(kv_shape), k_norm_g[2])
    v_s = v_s.reshape(kv_shape)
    v_w = v_w.reshape(kv_shape)
    kc = rms_norm(compress(k_c.reshape(kv_shape), cmp_pos_k, w_cmp_k), k_norm_g[0])
    vc = compress(v_c.reshape(kv_shape), cmp_pos_v, w_cmp_v)

    slopes = alibi_slopes()
    t = jnp.arange(S_)

    nc = kc.shape[1]
    c_start = jnp.arange(nc) * CMP_STRIDE
    c_end = c_start + CMP_BLOCK - 1
    dist_c = (t[:, None] - c_end[None, :]).astype(jnp.float32)
    s_c = (jnp.einsum('bsgrd,bcgd->bgrsc', q, kc).astype(jnp.float32) * SCALE
           - slopes[:, :, None, None] * dist_c)
    p_c = masked_softmax(s_c, dist_c >= 0)
    o_cmp = jnp.einsum('bgrsc,bcgd->bsgrd', p_c.astype(vc.dtype), vc)

    ns = S_ // SLC_BLOCK
    s_start = jnp.arange(ns) * SLC_BLOCK
    overlap = jnp.clip(jnp.minimum(c_start[:, None] + CMP_BLOCK, s_start[None, :] + SLC_BLOCK)
                       - jnp.maximum(c_start[:, None], s_start[None, :]), 0, None)
    overlap = overlap.astype(jnp.float32) / CMP_BLOCK
    imp = jnp.einsum('bgrsc,cj->bgsj', p_c, overlap)
    cur = (t // SLC_BLOCK)[:, None]
    j = jnp.arange(ns)[None, :]
    forced = (j == 0) | (j == cur) | (j == cur - 1)
    score = jnp.where(forced, FORCE_SCORE, jnp.where(j <= cur, imp, -1.0))
    n_sel = min(N_SLC, ns)
    _, sel_idx = lax.top_k(score, n_sel)

    kb = k_s.reshape(B_, ns, SLC_BLOCK, N_KV, HEAD_DIM).transpose(0, 3, 1, 2, 4)
    vb = v_s.reshape(B_, ns, SLC_BLOCK, N_KV, HEAD_DIM).transpose(0, 3, 1, 2, 4)
    gather = jax.vmap(jax.vmap(lambda blk, ids: blk[ids]))
    m_sel = n_sel * SLC_BLOCK

    def sel_chunk(i):
        start = i * SLC_Q_BLOCK
        q_i = lax.dynamic_slice_in_dim(q, start, SLC_Q_BLOCK, axis=1)
        idx_i = lax.dynamic_slice_in_dim(sel_idx, start, SLC_Q_BLOCK, axis=2)
        t_i = start + jnp.arange(SLC_Q_BLOCK)
        ks = gather(kb, idx_i).reshape(B_, N_KV, SLC_Q_BLOCK, m_sel, HEAD_DIM)
        vs = gather(vb, idx_i).reshape(B_, N_KV, SLC_Q_BLOCK, m_sel, HEAD_DIM)
        pos = (idx_i[..., None] * SLC_BLOCK + jnp.arange(SLC_BLOCK)).reshape(B_, N_KV, SLC_Q_BLOCK, m_sel)
        dist = (t_i[None, None, :, None] - pos).astype(jnp.float32)
        s = (jnp.einsum('bqgrd,bgqmd->bgrqm', q_i, ks).astype(jnp.float32) * SCALE
             - slopes[None, :, :, None, None] * dist[:, :, None])
        p = masked_softmax(s, (dist >= 0)[:, :, None])
        return jnp.einsum('bgrqm,bgqmd->bqgrd', p.astype(vs.dtype), vs)

    o_slc = lax.map(sel_chunk, jnp.arange(S_ // SLC_Q_BLOCK))
    o_slc = o_slc.transpose(1, 0, 2, 3, 4, 5).reshape(B_, S_, N_KV, GQA, HEAD_DIM)

    kp = jnp.pad(k_w, ((0, 0), (WINDOW, 0), (0, 0), (0, 0)))
    vp = jnp.pad(v_w, ((0, 0), (WINDOW, 0), (0, 0), (0, 0)))
    span = WINDOW + Q_BLOCK

    def win_chunk(i):
        start = i * Q_BLOCK
        q_i = lax.dynamic_slice_in_dim(q, start, Q_BLOCK, axis=1)
        k_i = lax.dynamic_slice_in_dim(kp, start, span, axis=1)
        v_i = lax.dynamic_slice_in_dim(vp, start, span, axis=1)
        t_i = start + jnp.arange(Q_BLOCK)
        s_pos = start - WINDOW + jnp.arange(span)
        dist = t_i[:, None] - s_pos[None, :]
        mask = (dist >= 0) & (dist < WINDOW) & (s_pos[None, :] >= 0)
        s = (jnp.einsum('bqgrd,bkgd->bgrqk', q_i, k_i).astype(jnp.float32) * SCALE
             - slopes[:, :, None, None] * dist.astype(jnp.float32))
        p = masked_softmax(s, mask)
        return jnp.einsum('bgrqk,bkgd->bqgrd', p.astype(v_i.dtype), v_i)

    o_win = lax.map(win_chunk, jnp.arange(S_ // Q_BLOCK))
    o_win = o_win.transpose(1, 0, 2, 3, 4, 5).reshape(B_, S_, N_KV, GQA, HEAD_DIM)

    g = jax.nn.sigmoid(g_nsa.astype(jnp.float32)).astype(x.dtype).reshape(B_, S_, 3, N_KV, GQA, 1)
    o_nsa = (g[:, :, 0] * o_cmp + g[:, :, 1] * o_slc + g[:, :, 2] * o_win).reshape(B_, S_, QW)

    u = conv_c * conv_x
    y = lax.conv_general_dilated(u, conv_w[:, None, :], window_strides=(1,),
                                 padding=[(CONV_K - 1, 0)],
                                 dimension_numbers=('NWC', 'WIO', 'NWC'),
                                 feature_group_count=CONV_WIDTH)
    z = conv_b * y

    mixed = (jax.nn.sigmoid(gate_a) * (o_nsa @ w_branch_a)
             + jax.nn.sigmoid(gate_b) * (z @ w_branch_b))
    x = x + mixed @ w_out

    h = rms_norm(x, norm2_g)
    return x + jnp.square(jax.nn.relu(h @ w_up)) @ w_down


def setup_inputs(seed: int = 0) -> dict:
    key = jax.random.key(seed)
    ks = jax.random.split(key, 16)
    nrm = jax.random.normal
    L = DEPTH
    return {
        "x": nrm(ks[0], (BATCH, SEQ, D_MODEL), jnp.float32),
        "norm1_g": 1.0 + 0.1 * nrm(ks[1], (L, D_MODEL), jnp.float32),
        "w_in": nrm(ks[2], (L, D_MODEL, PROJ_WIDTH), jnp.float32) * D_MODEL ** -0.5,
        "q_norm_g": 1.0 + 0.1 * nrm(ks[3], (L, HEAD_DIM), jnp.float32),
        "k_norm_g": 1.0 + 0.1 * nrm(ks[4], (L, 3, HEAD_DIM), jnp.float32),
        "cmp_pos_k": 0.1 * nrm(ks[5], (L, CMP_BLOCK, HEAD_DIM), jnp.float32),
        "cmp_pos_v": 0.1 * nrm(ks[6], (L, CMP_BLOCK, HEAD_DIM), jnp.float32),
        "w_cmp_k": nrm(ks[7], (L, CMP_BLOCK * HEAD_DIM, HEAD_DIM), jnp.float32) * (CMP_BLOCK * HEAD_DIM) ** -0.5,
        "w_cmp_v": nrm(ks[8], (L, CMP_BLOCK * HEAD_DIM, HEAD_DIM), jnp.float32) * (CMP_BLOCK * HEAD_DIM) ** -0.5,
        "conv_w": nrm(ks[9], (L, CONV_K, CONV_WIDTH), jnp.float32) * CONV_K ** -0.5,
        "w_branch_a": nrm(ks[10], (L, QW, D_MODEL), jnp.float32) * QW ** -0.5,
        "w_branch_b": nrm(ks[11], (L, CONV_WIDTH, D_MODEL), jnp.float32) * CONV_WIDTH ** -0.5,
        "w_out": nrm(ks[12], (L, D_MODEL, D_MODEL), jnp.float32) * D_MODEL ** -0.5,
        "norm2_g": 1.0 + 0.1 * nrm(ks[13], (L, D_MODEL), jnp.float32),
        "w_up": nrm(ks[14], (L, D_MODEL, D_FF), jnp.float32) * D_MODEL ** -0.5,
        "w_down": nrm(ks[15], (L, D_FF, D_MODEL), jnp.float32) * D_FF ** -0.5,
    }


def reference(x, norm1_g, w_in, q_norm_g, k_norm_g, cmp_pos_k, cmp_pos_v,
              w_cmp_k, w_cmp_v, conv_w, w_branch_a, w_branch_b, w_out,
              norm2_g, w_up, w_down):
    for l in range(DEPTH):
        x = hybrid_layer(x, norm1_g[l], w_in[l], q_norm_g[l], k_norm_g[l],
                         cmp_pos_k[l], cmp_pos_v[l], w_cmp_k[l], w_cmp_v[l],
                         conv_w[l], w_branch_a[l], w_branch_b[l], w_out[l],
                         norm2_g[l], w_up[l], w_down[l])
    return x
```

```cpp
#include <hip/hip_runtime.h>
#include <hip/hip_cooperative_groups.h>
#include <cstdio>
#include <cstdint>
namespace cg = cooperative_groups;
namespace pg8 {
#define PG8_LAS __attribute__((address_space(3)))
typedef unsigned short bf16_t;
typedef short bf16x8 __attribute__((ext_vector_type(8)));
typedef float f32x4 __attribute__((ext_vector_type(4)));
typedef unsigned u32x4 __attribute__((ext_vector_type(4)));
constexpr int BM = 256, BK = 64, HALF = 128, HTB = HALF * BK * 2  , STAGE_BYTES = 8 * HTB, NXCD = 8, WGM = 8;

__host__ __device__ __forceinline__ int lds_byte(int r, int c) { const int st = (r >> 4) * 2 + (c >> 5), rr = r & 15, cc = c & 31, ob = rr * 64 + cc * 2; return st * 1024 + (ob ^ (((ob >> 9) & 1) << 5)); }
__host__ __device__ __forceinline__ void stage_rc(int b, int& R, int& C) { const int st = b / 1024, sb = b % 1024, swz = sb ^ (((sb >> 9) & 1) << 5); R = (st >> 1) * 16 + swz / 64; C = (st & 1) * 32 + (swz % 64) / 2; }
__host__ __device__ __forceinline__ int perm32(int rho) { const int n = rho >> 4, i = rho & 15; return 8 * (i >> 2) + 4 * n + (i & 3); }

struct Unit { int pm, pn; };
struct Gemm { const bf16_t* A; const bf16_t* Bt; int M, N, K; };

struct StaticOrder {
    int nM, nN, nwg, G, c;
    __host__ __device__ void init(int M, int N, int G_, int c_) { nM = M / BM; nN = N / BM; nwg = nM * nN; G = G_; c = c_; }
    __host__ __device__ bool next(int i, Unit& u) const {
        const long L = (long)i * G + c; if (L >= nwg) return false;
        int wgid = (int)L; { const int q = nwg / NXCD, r = nwg % NXCD, xcd = wgid % NXCD, off = wgid / NXCD; wgid = (xcd < r ? xcd * (q + 1) : r * (q + 1) + (xcd - r) * q) + off; }
        const int nig = WGM * nN, gid = wgid / nig, fm = gid * WGM, gsz = (nM - fm) < WGM ? (nM - fm) : WGM;
        u.pm = fm + ((wgid % nig) % gsz); u.pn = (wgid % nig) / gsz; return true;
    }
    __device__ __forceinline__ void a_ready(const Unit&) const {}
    __device__ __forceinline__ void done(const Unit&) const {}
};

typedef float pg8_f32x2_t __attribute__((ext_vector_type(2))); typedef __bf16 pg8_bf16x2_t __attribute__((ext_vector_type(2)));
__device__ __forceinline__ unsigned cvt_pk_bf16(float lo, float hi) { pg8_f32x2_t v = {lo, hi}; pg8_bf16x2_t b = __builtin_convertvector(v, pg8_bf16x2_t); return __builtin_bit_cast(unsigned, b); }
typedef float f32x2 __attribute__((ext_vector_type(2)));
typedef unsigned u32x2 __attribute__((ext_vector_type(2)));
__device__ __forceinline__ float bflo(unsigned w) { return __uint_as_float(w << 16); }
__device__ __forceinline__ float bfhi(unsigned w) { return __uint_as_float(w & 0xffff0000u); }
__device__ __forceinline__ float sigm(float x) { return __builtin_amdgcn_rcpf(1.f + __expf(-x)); }

struct EpiProj {
    static constexpr bool PERM = true, AFTER_DRAIN = false; static constexpr int MID_T = 0; static constexpr bool HAS_PRE = false;
    bf16_t *Q, *KV, *U, *CB, *GA, *GB, *GN, *VT;
    static __device__ __forceinline__ u32x4 pack(const f32x4& v0, const f32x4& v1) { u32x4 w; w.x = cvt_pk_bf16(v0[0], v0[1]); w.y = cvt_pk_bf16(v0[2], v0[3]); w.z = cvt_pk_bf16(v1[0], v1[1]); w.w = cvt_pk_bf16(v1[2], v1[3]); return w; }
    __device__ __forceinline__ void plain(const f32x4 (&acc)[2][2][4][2], bf16_t* base, int ldc, int row0, int col0) const {
#pragma unroll
        for (int ai = 0; ai < 2; ++ai)
#pragma unroll
            for (int m = 0; m < 4; ++m) {
                bf16_t* rowp = base + (size_t)(row0 + ai * HALF + m * 16) * ldc + col0;
#pragma unroll
                for (int bj = 0; bj < 2; ++bj) *(u32x4*)(rowp + bj * HALF) = pack(acc[ai][bj][m][0], acc[ai][bj][m][1]);
            }
    }
    __device__ __forceinline__ void operator()(const f32x4 (&acc)[2][2][4][2], const Unit& u, int wr, int wc, int fr, int fq) const {
        const int pn = u.pn, row0 = u.pm * BM + wr * 64 + fr, cw = wc * 32 + 8 * fq;
        if (pn < 2) plain(acc, Q, 512, row0, pn * 256 + cw);
        else if (pn == 2) plain(acc, KV, 768, row0, cw);
        else if (pn < 5) {
#pragma unroll
            for (int ai = 0; ai < 2; ++ai)
#pragma unroll
                for (int m = 0; m < 4; ++m) {
                    const int row = row0 + ai * HALF + m * 16;
                    *(u32x4*)(KV + (size_t)row * 768 + (pn - 2) * 256 + cw) = pack(acc[ai][0][m][0], acc[ai][0][m][1]);
                    const u32x4 w = pack(acc[ai][1][m][0], acc[ai][1][m][1]);
                    bf16_t* vt = VT + ((size_t)((((row >> 12) * 2 + (pn - 3)) * 2 + (wc >> 1)) * 64 + (wc & 1) * 32 + 8 * fq)) * 4096 + (row & 4095);
                    vt[0 * 4096] = (bf16_t)(w.x & 0xffffu); vt[1 * 4096] = (bf16_t)(w.x >> 16); vt[2 * 4096] = (bf16_t)(w.y & 0xffffu); vt[3 * 4096] = (bf16_t)(w.y >> 16);
                    vt[4 * 4096] = (bf16_t)(w.z & 0xffffu); vt[5 * 4096] = (bf16_t)(w.z >> 16); vt[6 * 4096] = (bf16_t)(w.w & 0xffffu); vt[7 * 4096] = (bf16_t)(w.w >> 16);
                }
        } else if (pn < 13) {
#pragma unroll
            for (int ai = 0; ai < 2; ++ai)
#pragma unroll
                for (int m = 0; m < 4; ++m)
                    *(u32x4*)(U + (size_t)(row0 + ai * HALF + m * 16) * 1024 + (pn - 5) * 128 + cw) = pack(acc[ai][0][m][0] * acc[ai][1][m][0], acc[ai][0][m][1] * acc[ai][1][m][1]);
        } else if (pn < 17) plain(acc, CB, 1024, row0, (pn - 13) * 256 + cw);
        else if (pn < 25) {
#pragma unroll
            for (int ai = 0; ai < 2; ++ai)
#pragma unroll
                for (int m = 0; m < 4; ++m) {
                    f32x4 a0 = acc[ai][0][m][0], a1 = acc[ai][0][m][1], b0 = acc[ai][1][m][0], b1 = acc[ai][1][m][1];
#pragma unroll
                    for (int i = 0; i < 4; ++i) { b0[i] = sigm(b0[i]); b1[i] = sigm(b1[i]); a0[i] = sigm(a0[i]) * __builtin_amdgcn_rcpf(b0[i]); a1[i] = sigm(a1[i]) * __builtin_amdgcn_rcpf(b1[i]); }
                    const size_t off = (size_t)(row0 + ai * HALF + m * 16) * 1024 + (pn - 17) * 128 + cw;
                    __builtin_nontemporal_store(pack(a0, a1), (u32x4*)(GA + off)); __builtin_nontemporal_store(pack(b0, b1), (u32x4*)(GB + off));
                }
        } else if (wc == 0) {
#pragma unroll
            for (int ai = 0; ai < 2; ++ai)
#pragma unroll
                for (int m = 0; m < 4; ++m) {
                    f32x4 v0 = acc[ai][0][m][0], v1 = acc[ai][0][m][1];
#pragma unroll
                    for (int i = 0; i < 4; ++i) { v0[i] = sigm(v0[i]); v1[i] = sigm(v1[i]); }
                    *(u32x4*)(GN + (size_t)(row0 + ai * HALF + m * 16) * 32 + 8 * fq) = pack(v0, v1);
                }
        }
    }
};
struct EpiMix {
    static constexpr bool PERM = true, AFTER_DRAIN = false; static constexpr int MID_T = 8; static constexpr bool HAS_PRE = false;
    const bf16_t* GA; const bf16_t* GB; bf16_t* O; int ldc;
    __device__ __forceinline__ void mid(f32x4 (&acc)[2][2][4][2], const Unit& u, int wr, int wc, int fr, int fq) const {
        int row0 = u.pm * BM + wr * 64 + fr, col0 = u.pn * BM + wc * 32 + 8 * fq;
        asm volatile("" : "+v"(row0), "+v"(col0));
#pragma unroll
        for (int ai = 0; ai < 2; ++ai)
#pragma unroll
            for (int m = 0; m < 4; ++m)
#pragma unroll
                for (int bj = 0; bj < 2; ++bj) {
                    const size_t off = (size_t)(row0 + ai * HALF + m * 16) * ldc + col0 + bj * HALF;
                    const u32x4 a = *(const u32x4*)(GA + off);
                    acc[ai][bj][m][0] *= (f32x4){bflo(a.x), bfhi(a.x), bflo(a.y), bfhi(a.y)}; acc[ai][bj][m][1] *= (f32x4){bflo(a.z), bfhi(a.z), bflo(a.w), bfhi(a.w)};
                }
    }
    __device__ __forceinline__ void operator()(const f32x4 (&acc)[2][2][4][2], const Unit& u, int wr, int wc, int fr, int fq) const {
        const int row0 = u.pm * BM + wr * 64 + fr, col0 = u.pn * BM + wc * 32 + 8 * fq;
        u32x4 g[2][4][2];
#pragma unroll
        for (int ai = 0; ai < 2; ++ai)
#pragma unroll
            for (int m = 0; m < 4; ++m)
#pragma unroll
                for (int bj = 0; bj < 2; ++bj) g[ai][m][bj] = *(const u32x4*)(GB + (size_t)(row0 + ai * HALF + m * 16) * ldc + col0 + bj * HALF);
#pragma unroll
        for (int ai = 0; ai < 2; ++ai)
#pragma unroll
            for (int m = 0; m < 4; ++m)
#pragma unroll
                for (int bj = 0; bj < 2; ++bj) {
                    const size_t off = (size_t)(row0 + ai * HALF + m * 16) * ldc + col0 + bj * HALF;
                    const u32x4 gg = g[ai][m][bj];
                    const f32x4 v0 = acc[ai][bj][m][0], v1 = acc[ai][bj][m][1];
                    u32x4 w;
                    w.x = cvt_pk_bf16(bflo(gg.x) * v0[0], bfhi(gg.x) * v0[1]);
                    w.y = cvt_pk_bf16(bflo(gg.y) * v0[2], bfhi(gg.y) * v0[3]);
                    w.z = cvt_pk_bf16(bflo(gg.z) * v1[0], bfhi(gg.z) * v1[1]);
                    w.w = cvt_pk_bf16(bflo(gg.w) * v1[2], bfhi(gg.w) * v1[3]);
                    *(u32x4*)(O + off) = w;
                }
    }
};
struct EpiX1 {
    static constexpr bool PERM = false, AFTER_DRAIN = false; static constexpr int MID_T = 0; static constexpr bool HAS_PRE = false;
    const float* x; bf16_t* xb; float* rowss;
    __device__ __forceinline__ void operator()(const f32x4 (&acc)[2][2][4][2], const Unit& u, int wr, int wc, int fr, int fq) const {
        const int row0 = u.pm * BM + wr * 64 + fr, col0 = u.pn * BM + wc * 32 + 4 * fq;
        f32x4 xa[2][2][2], xb_[2][2][2];
#define X1_LOAD(dst, g) do { _Pragma("unroll") for (int mm = 0; mm < 2; ++mm) _Pragma("unroll") for (int bj = 0; bj < 2; ++bj) _Pragma("unroll") for (int n = 0; n < 2; ++n) \
            dst[mm][bj][n] = *(const f32x4*)(x + (size_t)(row0 + ((g) >> 1) * HALF + (2 * ((g) & 1) + mm) * 16) * 1024 + col0 + bj * HALF + n * 16); } while (0)
#define X1_STORE(src, g) do { _Pragma("unroll") for (int mm = 0; mm < 2; ++mm) { const int ai = (g) >> 1, m = 2 * ((g) & 1) + mm, row = row0 + ai * HALF + m * 16; float ss = 0.f; \
            _Pragma("unroll") for (int bj = 0; bj < 2; ++bj) _Pragma("unroll") for (int n = 0; n < 2; ++n) { const size_t off = (size_t)row * 1024 + col0 + bj * HALF + n * 16; \
                const f32x4 vv = src[mm][bj][n] + acc[ai][bj][m][n]; ss += (vv[0] * vv[0] + vv[1] * vv[1]) + (vv[2] * vv[2] + vv[3] * vv[3]); \
                u32x2 w; w.x = cvt_pk_bf16(vv[0], vv[1]); w.y = cvt_pk_bf16(vv[2], vv[3]); *(u32x2*)(xb + off) = w; } \
            ss += __shfl_xor(ss, 16); ss += __shfl_xor(ss, 32); if (fq == 0) atomicAdd(rowss + row, ss); } } while (0)
        X1_LOAD(xa, 0); X1_LOAD(xb_, 1);
        X1_STORE(xa, 0); X1_LOAD(xa, 2);
        X1_STORE(xb_, 1); X1_LOAD(xb_, 3);
        X1_STORE(xa, 2);
        X1_STORE(xb_, 3);
#undef X1_LOAD
#undef X1_STORE
    }
};
struct EpiUp {
    static constexpr bool PERM = true, AFTER_DRAIN = false; static constexpr int MID_T = 0; static constexpr bool HAS_PRE = true;
    const float* rowss; bf16_t* H; int ldc;
    mutable float rsv[2][4];
    __device__ __forceinline__ void pre(const Unit& u, int wr, int fr) const {
        const int row0 = u.pm * BM + wr * 64 + fr;
#pragma unroll
        for (int ai = 0; ai < 2; ++ai)
#pragma unroll
            for (int m = 0; m < 4; ++m) rsv[ai][m] = rowss[row0 + ai * HALF + m * 16];
    }
    __device__ __forceinline__ void operator()(const f32x4 (&acc)[2][2][4][2], const Unit& u, int wr, int wc, int fr, int fq) const {
        const int row0 = u.pm * BM + wr * 64 + fr, col0 = u.pn * BM + wc * 32 + 8 * fq;
#pragma unroll
        for (int ai = 0; ai < 2; ++ai)
#pragma unroll
            for (int m = 0; m < 4; ++m) {
                const int row = row0 + ai * HALF + m * 16;
                const float rs = __builtin_amdgcn_rsqf(rsv[ai][m] * (1.0f / 1024.0f) + 1e-6f);
#pragma unroll
                for (int bj = 0; bj < 2; ++bj) {
                    f32x4 v0 = acc[ai][bj][m][0] * rs, v1 = acc[ai][bj][m][1] * rs;
#pragma unroll
                    for (int i = 0; i < 4; ++i) { const float a = fmaxf(v0[i], 0.f), b = fmaxf(v1[i], 0.f); v0[i] = a * a; v1[i] = b * b; }
                    u32x4 w; w.x = cvt_pk_bf16(v0[0], v0[1]); w.y = cvt_pk_bf16(v0[2], v0[3]); w.z = cvt_pk_bf16(v1[0], v1[1]); w.w = cvt_pk_bf16(v1[2], v1[3]);
                    *(u32x4*)(H + (size_t)row * ldc + col0 + bj * HALF) = w;
                }
            }
    }
};
struct EpiDown {
    static constexpr bool PERM = false, AFTER_DRAIN = false; static constexpr int MID_T = 0; static constexpr bool HAS_PRE = false;
    const bf16_t* xb; float* out;
    __device__ __forceinline__ void operator()(const f32x4 (&acc)[2][2][4][2], const Unit& u, int wr, int wc, int fr, int fq) const {
        const int row0 = u.pm * BM + wr * 64 + fr, col0 = u.pn * BM + wc * 32 + 4 * fq;
        u32x2 xr[2][4][2][2];
#pragma unroll
        for (int ai = 0; ai < 2; ++ai)
#pragma unroll
            for (int m = 0; m < 4; ++m)
#pragma unroll
                for (int bj = 0; bj < 2; ++bj)
#pragma unroll
                    for (int n = 0; n < 2; ++n) xr[ai][m][bj][n] = *(const u32x2*)(xb + (size_t)(row0 + ai * HALF + m * 16) * 1024 + col0 + bj * HALF + n * 16);
#pragma unroll
        for (int ai = 0; ai < 2; ++ai)
#pragma unroll
            for (int m = 0; m < 4; ++m)
#pragma unroll
                for (int bj = 0; bj < 2; ++bj)
#pragma unroll
                    for (int n = 0; n < 2; ++n) { const u32x2 xw = xr[ai][m][bj][n];
                        *(f32x4*)(out + (size_t)(row0 + ai * HALF + m * 16) * 1024 + col0 + bj * HALF + n * 16) = (f32x4){bflo(xw.x), bfhi(xw.x), bflo(xw.y), bfhi(xw.y)} + acc[ai][bj][m][n]; }
    }
};
template <class Epi, class Sched, bool ALIGN_EPI = false, bool SP2 = false>
__device__ __forceinline__ void gemm_phase(PG8_LAS unsigned char* lds, const Gemm g, const Sched& S, const Epi& E) {
    int tid_ = threadIdx.x; asm volatile("" : "+v"(tid_));
    const int tid = tid_, wid = __builtin_amdgcn_readfirstlane(tid >> 6), lane = tid & 63, wr = wid >> 2, wc = wid & 3, fr = lane & 15, fq = lane >> 4;
    const int K = g.K, nt = K / BK;
    unsigned voffA[2], voffB[2];
#pragma unroll
    for (int i = 0; i < 2; ++i) { int R, C; stage_rc(tid * 16 + i * 8192, R, C); const int Rb = Epi::PERM ? ((R & ~31) + perm32(R & 31)) : R;
        voffA[i] = (unsigned)(R * K + C) * 2u; voffB[i] = (unsigned)(Rb * K + C) * 2u; }
    const size_t kstep = (size_t)(BK * 2);
    const size_t hstep = (size_t)HALF * K * 2;
    const size_t tstep = 2 * hstep;
    const unsigned ldsw = (unsigned)wid * 1024u;
    const int aoff = lds_byte(wr * 64 + fr, fq * 8), boff = lds_byte(wc * 32 + fr, fq * 8);
#define PG8_SA(b, h) (((b) * 2 + (h)) * HTB)
#define PG8_SB(b, h) ((4 + (b) * 2 + (h)) * HTB)
#define PG8_STAGE(bufoff, gbase, voff) do { _Pragma("unroll") for (int _i = 0; _i < 2; ++_i) \
        __builtin_amdgcn_global_load_lds((const unsigned*)((const char*)(gbase) + (voff)[_i]), (PG8_LAS unsigned*)(lds + (bufoff) + ldsw + _i * 8192), 16, 0, 0); } while (0)
#define PG8_LDA(dst, b, h) do { _Pragma("unroll") for (int m = 0; m < 4; ++m) _Pragma("unroll") for (int k = 0; k < 2; ++k) dst[m][k] = *(const PG8_LAS bf16x8*)(lds + PG8_SA(b, h) + aoff + m * 2048 + k * 1024); } while (0)
#define PG8_LDB(dst, b, h) do { _Pragma("unroll") for (int n = 0; n < 2; ++n) _Pragma("unroll") for (int k = 0; k < 2; ++k) dst[n][k] = *(const PG8_LAS bf16x8*)(lds + PG8_SB(b, h) + boff + n * 2048 + k * 1024); } while (0)
#define PG8_MMA(ai, bj, At, Bt) do { __builtin_amdgcn_s_setprio(1); _Pragma("unroll") for (int m = 0; m < 4; ++m) _Pragma("unroll") for (int n = 0; n < 2; ++n) _Pragma("unroll") for (int k = 0; k < 2; ++k) \
        acc[ai][bj][m][n] = __builtin_amdgcn_mfma_f32_16x16x32_bf16(Bt[n][k], At[m][k], acc[ai][bj][m][n], 0, 0, 0); __builtin_amdgcn_s_setprio(0); } while (0)
#define PG8_WAIT_V(n) asm volatile("s_waitcnt vmcnt(" #n ")" ::: "memory")
#define PG8_WAIT_L(n) asm volatile("s_waitcnt lgkmcnt(" #n ")" ::: "memory")
#define PG8_BAR __builtin_amdgcn_s_barrier()
#define PG8_SCHED __builtin_amdgcn_sched_barrier(0)
    Unit cur, nxt; int ui = 0;
    if (!S.next(0, cur)) return;
    f32x4 acc[2][2][4][2];
#pragma unroll
    for (int a = 0; a < 2; ++a)
#pragma unroll
        for (int b = 0; b < 2; ++b)
#pragma unroll
            for (int m = 0; m < 4; ++m)
#pragma unroll
                for (int n = 0; n < 2; ++n) acc[a][b][m][n] = (f32x4){0.f, 0.f, 0.f, 0.f};
    bf16x8 At[4][2], B0[2][2], B1[2][2];
    const char* cA = (const char*)g.A + (size_t)cur.pm * tstep; const char* cB = (const char*)g.Bt + (size_t)cur.pn * tstep;
    S.a_ready(cur);
    if constexpr (SP2) {
        PG8_STAGE(PG8_SB(0, 0), cB, voffB); PG8_STAGE(PG8_SB(0, 1), cB + hstep, voffB); PG8_STAGE(PG8_SA(0, 0), cA, voffA); PG8_STAGE(PG8_SA(0, 1), cA + hstep, voffA);
        if (wr == 1) PG8_BAR;
        PG8_WAIT_V(2); PG8_BAR;
        PG8_STAGE(PG8_SB(1, 0), cB + kstep, voffB); PG8_STAGE(PG8_SA(1, 0), cA + kstep, voffA); PG8_STAGE(PG8_SB(1, 1), cB + hstep + kstep, voffB);
        PG8_WAIT_V(6); PG8_BAR;
    } else {
        PG8_STAGE(PG8_SB(0, 0), cB, voffB); PG8_STAGE(PG8_SA(0, 0), cA, voffA); PG8_STAGE(PG8_SB(0, 1), cB + hstep, voffB); PG8_STAGE(PG8_SA(0, 1), cA + hstep, voffA);
        if (wr == 1) PG8_BAR;
        PG8_WAIT_V(4); PG8_BAR;
        PG8_STAGE(PG8_SB(1, 0), cB + kstep, voffB); PG8_STAGE(PG8_SA(1, 0), cA + kstep, voffA); PG8_STAGE(PG8_SB(1, 1), cB + hstep + kstep, voffB);
        PG8_WAIT_V(6); PG8_BAR;
    }
    for (;;) {
        const bool has_next = S.next(ui + 1, nxt);
        const char* nA = has_next ? (const char*)g.A + (size_t)nxt.pm * tstep : cA; const char* nB = has_next ? (const char*)g.Bt + (size_t)nxt.pn * tstep : cB;
        for (int t = 0; t < nt; t += 2) {
            if constexpr (Epi::MID_T > 0) { if (t == Epi::MID_T) E.mid(acc, cur, wr, wc, fr, fq); }
            const bool last = (t == nt - 2);
            const char* a1 = cA + (size_t)(t + 1) * kstep;
            const char* a2 = last ? nA : cA + (size_t)(t + 2) * kstep; const char* b2 = last ? nB : cB + (size_t)(t + 2) * kstep;
            const char* a3 = a2 + kstep; const char* b3 = b2 + kstep;
            if (last && has_next) S.a_ready(nxt);
            if constexpr (Epi::HAS_PRE) { if (last) E.pre(cur, wr, fr); }
            if constexpr (SP2) {
            PG8_LDB(B0, 0, 0); PG8_LDB(B1, 0, 1); PG8_SCHED; PG8_LDA(At, 0, 0); PG8_STAGE(PG8_SA(1, 1), a1 + hstep, voffA);
            PG8_WAIT_V(8); PG8_WAIT_L(0); PG8_BAR; PG8_MMA(0, 0, At, B0); PG8_MMA(0, 1, At, B1); PG8_BAR; PG8_SCHED;
            PG8_LDA(At, 0, 1); PG8_STAGE(PG8_SB(0, 0), b2, voffB); PG8_STAGE(PG8_SB(0, 1), b2 + hstep, voffB); PG8_STAGE(PG8_SA(0, 0), a2, voffA);
            PG8_WAIT_V(8); PG8_WAIT_L(0); PG8_BAR; PG8_MMA(1, 0, At, B0); PG8_MMA(1, 1, At, B1); PG8_BAR; PG8_SCHED;
            PG8_LDB(B0, 1, 0); PG8_LDB(B1, 1, 1); PG8_SCHED; PG8_LDA(At, 1, 0); PG8_STAGE(PG8_SA(0, 1), a2 + hstep, voffA);
            PG8_WAIT_V(8); PG8_WAIT_L(0); PG8_BAR; PG8_MMA(0, 0, At, B0); PG8_MMA(0, 1, At, B1); PG8_BAR; PG8_SCHED;
            PG8_LDA(At, 1, 1); PG8_STAGE(PG8_SB(1, 0), b3, voffB); PG8_STAGE(PG8_SB(1, 1), b3 + hstep, voffB); PG8_STAGE(PG8_SA(1, 0), a3, voffA);
            PG8_WAIT_V(8); PG8_WAIT_L(0); PG8_BAR; PG8_MMA(1, 0, At, B0); PG8_MMA(1, 1, At, B1); PG8_BAR; PG8_SCHED;
            } else {
            PG8_LDB(B0, 0, 0); PG8_SCHED; PG8_LDA(At, 0, 0); PG8_STAGE(PG8_SA(1, 1), a1 + hstep, voffA);
            PG8_WAIT_L(8); PG8_BAR; PG8_WAIT_L(0); PG8_MMA(0, 0, At, B0); PG8_BAR; PG8_SCHED;
            PG8_LDB(B1, 0, 1); PG8_STAGE(PG8_SB(0, 0), b2, voffB);
            PG8_BAR; PG8_WAIT_L(0); PG8_MMA(0, 1, At, B1); PG8_BAR;
            PG8_LDA(At, 0, 1); PG8_STAGE(PG8_SA(0, 0), a2, voffA);
            PG8_BAR; PG8_WAIT_L(0); PG8_MMA(1, 0, At, B0); PG8_BAR; PG8_SCHED;
            PG8_STAGE(PG8_SB(0, 1), b2 + hstep, voffB);
            PG8_WAIT_V(6); PG8_BAR; PG8_MMA(1, 1, At, B1); PG8_BAR;
            PG8_LDB(B0, 1, 0); PG8_SCHED; PG8_LDA(At, 1, 0); PG8_STAGE(PG8_SA(0, 1), a2 + hstep, voffA);
            PG8_WAIT_L(8); PG8_BAR; PG8_WAIT_L(0); PG8_MMA(0, 0, At, B0); PG8_BAR; PG8_SCHED;
            PG8_LDB(B1, 1, 1); PG8_STAGE(PG8_SB(1, 0), b3, voffB);
            PG8_BAR; PG8_WAIT_L(0); PG8_MMA(0, 1, At, B1); PG8_BAR;
            PG8_LDA(At, 1, 1); PG8_STAGE(PG8_SA(1, 0), a3, voffA);
            PG8_BAR; PG8_WAIT_L(0); PG8_MMA(1, 0, At, B0); PG8_BAR; PG8_SCHED;
            PG8_STAGE(PG8_SB(1, 1), b3 + hstep, voffB);
            PG8_WAIT_V(6); PG8_BAR; PG8_MMA(1, 1, At, B1); PG8_BAR;
            }
        }
        if constexpr (ALIGN_EPI) { if (wr == 0) PG8_BAR; }
        if constexpr (!Epi::AFTER_DRAIN) { E(acc, cur, wr, wc, fr, fq); S.done(cur); }
        if (!has_next) break;
#pragma unroll
        for (int a = 0; a < 2; ++a)
#pragma unroll
            for (int b = 0; b < 2; ++b)
#pragma unroll
                for (int m = 0; m < 4; ++m)
#pragma unroll
                    for (int n = 0; n < 2; ++n) acc[a][b][m][n] = (f32x4){0.f, 0.f, 0.f, 0.f};
        cur = nxt; cA = nA; cB = nB; ++ui;
        if constexpr (ALIGN_EPI) { if (wr == 1) PG8_BAR; }
    }
    PG8_WAIT_V(0);
    if constexpr (!ALIGN_EPI) { if (wr == 0) PG8_BAR; }
    PG8_BAR;
    if constexpr (Epi::AFTER_DRAIN) { E.fused(acc, cur, wr, wc, fr, fq, lds, wid, lane); S.done(cur); }
#undef PG8_SA
#undef PG8_SB
#undef PG8_STAGE
#undef PG8_LDA
#undef PG8_LDB
#undef PG8_MMA
#undef PG8_WAIT_V
#undef PG8_WAIT_L
#undef PG8_BAR
#undef PG8_SCHED
}
}

constexpr int BATCH = 8, SEQ = 4096, DM = 1024, M = BATCH * SEQ, NPROJ = 6424, NPAD = 6656, DFF = 4096;
constexpr float EPS = 1e-6f, LOG2E = 1.4426950408889634f;
constexpr int NWAVES = 8;
constexpr size_t MiB = 1u << 20;
constexpr size_t WS_ROWSS = 0;
constexpr size_t WS_WIN = 2 * MiB, WS_WAB = 15 * MiB  , WS_WO = 18 * MiB, WS_WUP = 20 * MiB, WS_WDN = 28 * MiB;
constexpr size_t WS_WC = 36 * MiB;
constexpr size_t WS_POSB = 36 * MiB + 512 * 1024;
constexpr size_t WS_KCN = 37 * MiB;
constexpr size_t WS_VCT = 38 * MiB;
constexpr size_t WS_VT = 480 * MiB;
constexpr size_t WS_GN = 43 * MiB;
constexpr size_t WS_XN = 48 * MiB;
constexpr size_t WS_Q = 112 * MiB;
constexpr size_t WS_KV = 144 * MiB;
constexpr size_t WS_U = 192 * MiB;
constexpr size_t WS_CB = 256 * MiB;
constexpr size_t WS_ZO = 320 * MiB;
constexpr size_t WS_MIX = 112 * MiB;
constexpr size_t WS_H = 192 * MiB;
constexpr size_t WS_END = 496 * MiB;
constexpr int RING_BYTES = 131072, LDS_BYTES = 147456, MISC_OFF = RING_BYTES + 320;
constexpr size_t WS_BAR = 1 * MiB;

#define LAS __attribute__((address_space(3)))
typedef unsigned short bf16;
typedef unsigned v4u __attribute__((ext_vector_type(4)));
typedef unsigned v2u __attribute__((ext_vector_type(2)));
typedef float f32x4 __attribute__((ext_vector_type(4)));
typedef float f32x16 __attribute__((ext_vector_type(16)));
typedef short bf16x8 __attribute__((ext_vector_type(8)));
typedef short s16x4 __attribute__((ext_vector_type(4)));
typedef float f32x2_t __attribute__((ext_vector_type(2)));
typedef __bf16 bf16x2_t __attribute__((ext_vector_type(2)));
#define LDS_WAIT() asm volatile("s_waitcnt lgkmcnt(0)" ::: "memory")
#define MFMA32(a, b, c) __builtin_amdgcn_mfma_f32_32x32x16_bf16(a, b, c, 0, 0, 0)
__device__ __forceinline__ unsigned pk2(float lo, float hi) { f32x2_t v = {lo, hi}; bf16x2_t b = __builtin_convertvector(v, bf16x2_t); return __builtin_bit_cast(unsigned, b); }
__device__ __forceinline__ float bf2f(bf16 h) { return __uint_as_float((unsigned)h << 16); }
__device__ __forceinline__ float blo(unsigned w) { return __uint_as_float(w << 16); }
__device__ __forceinline__ float bhi(unsigned w) { return __uint_as_float(w & 0xffff0000u); }
__device__ __forceinline__ bf16x8 pack8(float a0, float a1, float a2, float a3, float a4, float a5, float a6, float a7) {
    v4u w; w.x = pk2(a0, a1); w.y = pk2(a2, a3); w.z = pk2(a4, a5); w.w = pk2(a6, a7); return __builtin_bit_cast(bf16x8, w); }
__device__ __forceinline__ int crow(int r, int hi) { return (r & 3) + 8 * (r >> 2) + 4 * hi; }
__device__ __forceinline__ float ex2(float x) { return __builtin_amdgcn_exp2f(x); }

struct Args {
    const float *x, *norm1_g, *w_in, *q_norm_g, *k_norm_g, *cmp_pos_k, *cmp_pos_v, *w_cmp_k, *w_cmp_v, *conv_w, *w_branch_a, *w_branch_b, *w_out, *norm2_g, *w_up, *w_down;
    float* out; unsigned char* ws;
    int never; int pad;
};

#define XB_TMO      128
#define XB_XCNT(j)  (256  + 64 * (j))
#define XB_XSUB(j)  (1280 + 64 * (j))
#define XB_XGEN(j)  (2304 + 64 * (j))
#define XB_TOP      3328
#define XB_TOPGEN   3392
#define XCD_BAR_WORDS 3456
#define XB_SPIN_CAP (1u << 18)

__device__ __forceinline__ unsigned xb_ld(unsigned* p)              { return __hip_atomic_load(p, __ATOMIC_RELAXED, __HIP_MEMORY_SCOPE_AGENT); }
__device__ __forceinline__ unsigned xb_add(unsigned* p, unsigned v) { return __hip_atomic_fetch_add(p, v, __ATOMIC_RELAXED, __HIP_MEMORY_SCOPE_AGENT); }
__device__ __forceinline__ unsigned xb_xcc_id() { return (unsigned)__builtin_amdgcn_s_getreg((3 << 11) | 20) & 0xFu; }
#define XB_SPIN(cond, bar) do { unsigned _sp = 0; while (cond) { __builtin_amdgcn_s_sleep(1); \
    if ((++_sp & 255u) == 0u) { if (xb_ld(&(bar)[XB_TMO])) break; if (_sp > XB_SPIN_CAP) { atomicAdd(&(bar)[XB_TMO], 1u); break; } } } } while (0)

struct XcdBarrier {
    unsigned* bar; unsigned x;
    volatile LAS unsigned* st;
};

__device__ __forceinline__ XcdBarrier xcd_barrier_post(unsigned* bar, volatile LAS unsigned* st) {
    XcdBarrier b; b.bar = bar; b.x = xb_xcc_id(); b.st = st;
    if (threadIdx.x == 0) (void)xb_add(&bar[XB_XCNT(b.x)], 1u);
    return b;
}
__device__ __forceinline__ void xcd_barrier_complete(unsigned* bar, unsigned x, unsigned& nloc, unsigned& nx) {
    const unsigned G = gridDim.x * gridDim.y * gridDim.z;
    unsigned sum, cnt, mine, sp = 0u;
    for (;;) {
        sum = 0u; cnt = 0u; mine = 0u;
#pragma unroll
        for (unsigned j = 0; j < 16; ++j) { const unsigned c = xb_ld(&bar[XB_XCNT(j)]); sum += c; cnt += (c > 0u) ? 1u : 0u; mine = (j == x) ? c : mine; }
        if (sum == G) break;
        __builtin_amdgcn_s_sleep(1);
        if ((++sp & 255u) == 0u) { if (xb_ld(&bar[XB_TMO])) break; if (sp > XB_SPIN_CAP) { atomicAdd(&bar[XB_TMO], 1u); break; } }
    }
    nloc = mine > 0u ? mine : 1u; nx = cnt > 0u ? cnt : 1u;
}

__device__ __forceinline__ void xcd_barrier(const XcdBarrier& b) {
    asm volatile("s_waitcnt vmcnt(0)" ::: "memory");
    __syncthreads();
    if (threadIdx.x == 0) {
        unsigned* bar = b.bar;
        __builtin_amdgcn_s_waitcnt(0);
        unsigned nloc = b.st[0], nx = b.st[1];
        if (nloc == 0u) { xcd_barrier_complete(bar, b.x, nloc, nx); b.st[0] = nloc; b.st[1] = nx; }
        const unsigned old = xb_add(&bar[XB_XSUB(b.x)], 1u);
        const unsigned gen = old / nloc;
        if (old + 1u == (gen + 1u) * nloc) {
            __builtin_amdgcn_fence(__ATOMIC_RELEASE, "agent");
            asm volatile("s_waitcnt vmcnt(0)" ::: "memory");
            const unsigned og = xb_add(&bar[XB_TOP], 1u);
            const unsigned tg = og / nx;
            if (og + 1u == (tg + 1u) * nx) xb_add(&bar[XB_TOPGEN], 1u);
            else XB_SPIN(xb_ld(&bar[XB_TOPGEN]) == tg, bar);
            __builtin_amdgcn_fence(__ATOMIC_ACQUIRE, "agent");
            xb_add(&bar[XB_XGEN(b.x)], 1u);
            asm volatile("s_waitcnt vmcnt(0)" ::: "memory");
        } else {
            XB_SPIN(xb_ld(&bar[XB_XGEN(b.x)]) == gen, bar);
            __builtin_amdgcn_fence(__ATOMIC_ACQUIRE, "agent");
            asm volatile("s_waitcnt vmcnt(0)" ::: "memory");
        }
    }
    __syncthreads();
}

__device__ __forceinline__ int map_win(int ns) {
    if (ns < 1280) return ns;
    if (ns < 1304) return 6400 + (ns - 1280);
    if (ns < 2328) return 3328 + (ns - 1304);
    if (ns < 3352) { const int ch = ns - 2328; return 1280 + (ch >> 7) * 256 + (ch & 127); }
    if (ns < 4376) { const int ch = ns - 3352; return 1280 + (ch >> 7) * 256 + 128 + (ch & 127); }
    if (ns < 5400) { const int ch = ns - 4376; return 4352 + (ch >> 7) * 256 + (ch & 127); }
    { const int ch = ns - 5400; return 4352 + (ch >> 7) * 256 + 128 + (ch & 127); }
}
template <bool MAP> __device__ __forceinline__ void tr_item(const float* W, int K, int N, bf16* WT, int ldk, const float* kscale, LAS float* scr, int item, int lane) {
    const int nblk = (N + 31) / 32, kb = item / nblk, nb = item % nblk, k0 = 64 * kb, n0 = 32 * nb;
    const int nl = n0 + (lane & 31); const bool nok = nl < N;
    float tv[32];
#pragma unroll
    for (int i = 0; i < 32; ++i) { const int kk = 2 * i + (lane >> 5); tv[i] = nok ? __builtin_nontemporal_load(W + (size_t)(k0 + kk) * N + nl) : 0.f; }
#pragma unroll
    for (int i = 0; i < 32; ++i) { const int kk = 2 * i + (lane >> 5); float v = tv[i]; if (kscale) v *= kscale[k0 + kk]; scr[kk * 33 + (lane & 31)] = v; }
    LDS_WAIT(); asm volatile("" ::: "memory");
    const int c = lane & 7;
#pragma unroll
    for (int j = 0; j < 4; ++j) { const int n = (lane >> 3) + 8 * j, ns = n0 + n; const LAS float* s = scr + (8 * c) * 33 + n;
        if (ns < N) { const int dr = MAP ? map_win(ns) : ns;
            v4u o; o.x = pk2(s[0 * 33], s[1 * 33]); o.y = pk2(s[2 * 33], s[3 * 33]); o.z = pk2(s[4 * 33], s[5 * 33]); o.w = pk2(s[6 * 33], s[7 * 33]);
            *(v4u*)(WT + (size_t)dr * ldk + k0 + 8 * c) = o; } }
    LDS_WAIT(); asm volatile("" ::: "memory");
}
__device__ __forceinline__ float wave_sum(float v) {
#pragma unroll
    for (int o = 1; o < 64; o <<= 1) v += __shfl_xor(v, o);
    return v;
}

constexpr int L_KC = 0, L_VCT = 36864, L_K0 = 70144, L_V0 = 88576, L_SC = 105984, L_MB = 122368;
constexpr int KSTR = 72, VSTR = 68, VCSTR = 260;
static_assert(L_MB + 512 <= RING_BYTES, "attention LDS map");

__device__ __forceinline__ void attn_qk(const LAS unsigned char* Kb, const f32x16& cinit, const bf16x8 (&qf)[4], f32x16& p0, f32x16& p1, int r32, int hi) {
    p0 = cinit; p1 = cinit;
    bf16x8 ka[4], kb[4];
#pragma unroll
    for (int kk = 0; kk < 4; ++kk) {
        ka[kk] = *(const LAS bf16x8*)(Kb + (r32 * KSTR + 16 * kk + 8 * hi) * 2);
        kb[kk] = *(const LAS bf16x8*)(Kb + ((32 + r32) * KSTR + 16 * kk + 8 * hi) * 2);
    }
    __builtin_amdgcn_sched_barrier(0);
#pragma unroll
    for (int kk = 0; kk < 4; ++kk) { p0 = MFMA32(ka[kk], qf[kk], p0); p1 = MFMA32(kb[kk], qf[kk], p1); }
}
template <bool WIN>
__device__ __forceinline__ void attn_sp(const LAS unsigned char* Vb, int j, int cur, int tokl, unsigned long long lmask, float slope2,
                                        f32x16& p0, f32x16& p1, f32x16 (&o)[2], float& m, float& l, int r32, int hi) {
    const bool sel = (lmask >> j) & 1ull;
    const float T0 = slope2 * (float)(64 * j), T1 = T0 + 32.f * slope2;
    if (j == cur || (WIN && j == cur - 8)) {
        const int hl = (j == cur) ? tokl - 4 * hi : 99;
        const int ll = (WIN && j != cur) ? tokl - 4 * hi : -1;
#pragma unroll
        for (int r = 0; r < 16; ++r) {
            const int cr = (r & 3) + 8 * (r >> 2);
            p0[r] = (cr > ll && cr <= hl) ? p0[r] : -1e30f; p1[r] = (cr + 32 > ll && cr + 32 <= hl) ? p1[r] : -1e30f;
        }
    }
    float mx0 = fmaxf(fmaxf(p0[0], p0[1]), p0[2]), mx1 = fmaxf(fmaxf(p1[0], p1[1]), p1[2]);
#pragma unroll
    for (int r = 3; r < 15; r += 2) { mx0 = fmaxf(fmaxf(mx0, p0[r]), p0[r + 1]); mx1 = fmaxf(fmaxf(mx1, p1[r]), p1[r + 1]); }
    mx0 = fmaxf(mx0, p0[15]); mx1 = fmaxf(mx1, p1[15]);
    float bm = sel ? fmaxf(mx0 + T0, mx1 + T1) : -1e30f;
    bm = fmaxf(bm, __shfl_xor(bm, 32));
    if (__builtin_amdgcn_ballot_w64(bm > m - 24.0f) == 0ull) return;
    const float mn = fmaxf(m, bm);
    if (__builtin_amdgcn_ballot_w64(mn > m) != 0ull) {
        const float alpha = ex2(m - mn); l *= alpha;
#pragma unroll
        for (int r = 0; r < 16; ++r) { o[0][r] *= alpha; o[1][r] *= alpha; }
    }
    m = mn;
    const bool live = sel && (mn > -1e29f);
    const float c0 = live ? mn - T0 : 1e30f, c1 = live ? mn - T1 : 1e30f;
    p0 = p0 - c0; p1 = p1 - c1;
#pragma unroll
    for (int r = 0; r < 16; ++r) { p0[r] = ex2(p0[r]); p1[r] = ex2(p1[r]); }
    { const f32x16 ps = p0 + p1; l += ((ps[0] + ps[1]) + (ps[2] + ps[3])) + ((ps[4] + ps[5]) + (ps[6] + ps[7])) + ((ps[8] + ps[9]) + (ps[10] + ps[11])) + ((ps[12] + ps[13]) + (ps[14] + ps[15])); }
#pragma unroll
    for (int j4 = 0; j4 < 4; ++j4) {
        bf16x8 pb;
        if (j4 < 2) pb = pack8(p0[8 * (j4 & 1) + 0], p0[8 * (j4 & 1) + 1], p0[8 * (j4 & 1) + 2], p0[8 * (j4 & 1) + 3], p0[8 * (j4 & 1) + 4], p0[8 * (j4 & 1) + 5], p0[8 * (j4 & 1) + 6], p0[8 * (j4 & 1) + 7]);
        else        pb = pack8(p1[8 * (j4 & 1) + 0], p1[8 * (j4 & 1) + 1], p1[8 * (j4 & 1) + 2], p1[8 * (j4 & 1) + 3], p1[8 * (j4 & 1) + 4], p1[8 * (j4 & 1) + 5], p1[8 * (j4 & 1) + 6], p1[8 * (j4 & 1) + 7]);
#pragma unroll
        for (int d0 = 0; d0 < 2; ++d0) {
            const LAS unsigned char* vp = Vb + ((r32 + 32 * d0) * VSTR + 16 * j4 + 4 * hi) * 2;
            const s16x4 lo4 = *(const LAS s16x4*)vp, hi4 = *(const LAS s16x4*)(vp + 16);
            const bf16x8 a = (bf16x8){lo4[0], lo4[1], lo4[2], lo4[3], hi4[0], hi4[1], hi4[2], hi4[3]};
            o[d0] = MFMA32(a, pb, o[d0]);
        }
    }
}

template <bool WIN>
__device__ __forceinline__ void attn_branch(LAS unsigned char* L, const bf16* kvb, const bf16* vtb, unsigned long long umask, unsigned long long lmask,
                                            int cur, int tokl, float slope2, const f32x16& cinit, const bf16x8 (&qf)[4], f32x16 (&o)[2], float& l_out, int tid, int r32, int hi, bool skew, v4u k_first, v4u v_first) {
    o[0] = f32x16{}; o[1] = f32x16{}; float m = -1e30f, l = 0.f;
    const int srow = tid >> 3, sch = tid & 7;
    unsigned long long pend = umask;
#define POP(dst) do { if (pend) { dst = 63 - __builtin_clzll(pend); pend &= ~(1ull << dst); } else dst = -1; } while (0)
#define STAGE_LOAD(kr, vr, jj) do { kr = *(const v4u*)(kvb + (size_t)(64 * (jj) + srow) * 768 + sch * 8); vr = *(const v4u*)(vtb + (size_t)srow * SEQ + 64 * (jj) + sch * 8); } while (0)
#define STAGE_WRITE(kso, vso, kr, vr) do { \
        *(LAS v4u*)(L + L_K0 + (kso) + (srow * KSTR + sch * 8) * 2) = kr; \
        LAS v2u* vt_ = (LAS v2u*)(L + L_V0 + (vso) + (srow * VSTR + sch * 8) * 2); \
        vt_[0] = (v2u){vr.x, vr.y}; vt_[1] = (v2u){vr.z, vr.w}; } while (0)
    int jq0, jq1; POP(jq0); POP(jq1);
    v4u kA = k_first, vA = v_first;
    STAGE_WRITE(0, 0, kA, vA);
    if (jq1 >= 0) STAGE_LOAD(kA, vA, jq1);
    __syncthreads();
    int kso = 0, vso = 0, vsn = 8704, vsp = 0, jprev = -1;
    f32x16 p0, p1;
    for (;;) {
        int jq2 = -1;
        if (jq1 >= 0) { STAGE_WRITE(kso ^ 9216, vsn, kA, vA); POP(jq2); if (jq2 >= 0) STAGE_LOAD(kA, vA, jq2); }
        if (skew) {
            if (jprev >= 0) attn_sp<WIN>(L + L_V0 + vsp, jprev, cur, tokl, lmask, slope2, p0, p1, o, m, l, r32, hi);
            attn_qk(L + L_K0 + kso, cinit, qf, p0, p1, r32, hi);
        } else {
            attn_qk(L + L_K0 + kso, cinit, qf, p0, p1, r32, hi);
            attn_sp<WIN>(L + L_V0 + vso, jq0, cur, tokl, lmask, slope2, p0, p1, o, m, l, r32, hi);
        }
        __syncthreads();
        jprev = jq0; vsp = vso; vso = vsn; vsn = (vsn == 2 * 8704) ? 0 : vsn + 8704; kso ^= 9216;
        if (jq1 < 0) break;
        jq0 = jq1; jq1 = jq2;
    }
    if (skew) attn_sp<WIN>(L + L_V0 + vsp, jprev, cur, tokl, lmask, slope2, p0, p1, o, m, l, r32, hi);
    __syncthreads();
#undef POP
#undef STAGE_LOAD
#undef STAGE_WRITE
    l_out = l + __shfl_xor(l, 32);
}

struct AttnPtrs { const bf16 *Q, *KV, *GN, *KCN, *VCT, *VT; bf16* O; const float* qg; };

__device__ __forceinline__ void attn_unit(const AttnPtrs& A, LAS unsigned char* L, int b, int g, int cur) {
    int tid_ = threadIdx.x; asm volatile("" : "+v"(tid_));
    const int tid = tid_, lane = tid & 63, w = __builtin_amdgcn_readfirstlane(tid >> 6), r32 = lane & 31, hi = lane >> 5;
    const int tokl = 8 * w + (r32 >> 2), head = r32 & 3, hq = g * 4 + head, t = 64 * cur + tokl;
    const size_t mrow = (size_t)b * SEQ + t;
    const float slope2 = ex2(-(float)(hq + 1)) * LOG2E;
    bf16x8 qf[4];
    {
        const bf16* qp = A.Q + mrow * 512 + hq * 64 + 8 * hi;
        v4u qw[4]; float ss = 0.f;
#pragma unroll
        for (int kk = 0; kk < 4; ++kk) qw[kk] = *(const v4u*)(qp + 16 * kk);
#pragma unroll
        for (int kk = 0; kk < 4; ++kk) { const v4u w_ = qw[kk];
            ss += (blo(w_.x) * blo(w_.x) + bhi(w_.x) * bhi(w_.x)) + (blo(w_.y) * blo(w_.y) + bhi(w_.y) * bhi(w_.y)) + (blo(w_.z) * blo(w_.z) + bhi(w_.z) * bhi(w_.z)) + (blo(w_.w) * blo(w_.w) + bhi(w_.w) * bhi(w_.w)); }
        ss += __shfl_xor(ss, 32);
        const float rq = __builtin_amdgcn_rsqf(ss * (1.f / 64.f) + EPS) * (0.125f * LOG2E);
#pragma unroll
        for (int kk = 0; kk < 4; ++kk) { const v4u w_ = qw[kk]; const f32x4 ga = *(const f32x4*)(A.qg + 16 * kk + 8 * hi), gb = *(const f32x4*)(A.qg + 16 * kk + 8 * hi + 4);
            qf[kk] = pack8(blo(w_.x) * rq * ga[0], bhi(w_.x) * rq * ga[1], blo(w_.y) * rq * ga[2], bhi(w_.y) * rq * ga[3], blo(w_.z) * rq * gb[0], bhi(w_.z) * rq * gb[1], blo(w_.w) * rq * gb[2], bhi(w_.w) * rq * gb[3]); }
    }
    const float g0 = bf2f(A.GN[mrow * 32 + hq]), g1 = bf2f(A.GN[mrow * 32 + 8 + hq]), g2 = bf2f(A.GN[mrow * 32 + 16 + hq]);
    const int ncv = (4 * cur + 3 < 255) ? 4 * cur + 3 : 255, nblk = (ncv + 31) >> 5, nrow = nblk * 32;
    v4u kr[4], vr[4];
    {
        const bf16* kc = A.KCN + (size_t)(b * 2 + g) * 256 * 64; const bf16* vc = A.VCT + (size_t)(b * 2 + g) * 64 * 256;
#pragma unroll
        for (int i = 0; i < 4; ++i) {
            const int ck = i * 512 + tid, row = ck >> 3;
            kr[i] = (row < nrow) ? *(const v4u*)(kc + (size_t)ck * 8) : (v4u){0u, 0u, 0u, 0u};
            const int d = ck >> 5, cc = (ck & 31) * 8;
            vr[i] = (cc < nrow) ? *(const v4u*)(vc + (size_t)d * 256 + cc) : (v4u){0u, 0u, 0u, 0u};
        }
    }
    __syncthreads();
    {
#pragma unroll
        for (int i = 0; i < 4; ++i) {
            const int ck = i * 512 + tid, row = ck >> 3, d = ck >> 5, cc = (ck & 31) * 8;
            if (row < nrow) *(LAS v4u*)(L + L_KC + (row * KSTR + (ck & 7) * 8) * 2) = kr[i];
            if (cc < nrow) { LAS v2u* vp = (LAS v2u*)(L + L_VCT + (d * VCSTR + cc) * 2); vp[0] = (v2u){vr[i].x, vr[i].y}; vp[1] = (v2u){vr[i].z, vr[i].w}; }
        }
    }
    __syncthreads();
    f32x16 cinit;
#pragma unroll
    for (int r = 0; r < 16; ++r) cinit[r] = slope2 * (float)((r & 3) + 8 * (r >> 2) + 4 * hi);
    const int clim_l = ((t - 31) >> 4) - 4 * hi;
    const bool need_imp = cur >= 16;
    LAS f32x4* park = (LAS f32x4*)(L + w * 8192) + lane;
    float imp[33];
#pragma unroll
    for (int i = 0; i < 33; ++i) imp[i] = 0.f;
    {
        f32x16 oc[2]; oc[0] = f32x16{}; oc[1] = f32x16{};
        float m1 = -1e30f, l1 = 0.f;
#pragma unroll
        for (int bi = 0; bi < 8; ++bi) {
            const int blk = 7 - bi;
            if (blk < nblk) {
                f32x16 p = f32x16{};
                { bf16x8 kc4[4];
#pragma unroll
                  for (int kk = 0; kk < 4; ++kk) kc4[kk] = *(const LAS bf16x8*)(L + L_KC + ((32 * blk + r32) * KSTR + 16 * kk + 8 * hi) * 2);
                  __builtin_amdgcn_sched_barrier(0);
#pragma unroll
                  for (int kk = 0; kk < 4; ++kk) p = MFMA32(kc4[kk], qf[kk], p); }
                if (32 * blk + 31 > 4 * cur - 2) {
#pragma unroll
                    for (int r = 0; r < 16; ++r) p[r] = (32 * blk + (r & 3) + 8 * (r >> 2) <= clim_l) ? fmaf(cinit[r], 16.f, p[r]) : -1e30f;
                } else {
#pragma unroll
                    for (int r = 0; r < 16; ++r) p[r] = fmaf(cinit[r], 16.f, p[r]);
                }
                const float Tb = slope2 * 512.f * (float)blk;
                float mx = fmaxf(fmaxf(p[0], p[1]), p[2]);
#pragma unroll
                for (int r = 3; r < 15; r += 2) mx = fmaxf(fmaxf(mx, p[r]), p[r + 1]);
                mx = fmaxf(mx, p[15]);
                float bm = mx + Tb; bm = fmaxf(bm, __shfl_xor(bm, 32));
                const float mn = fmaxf(m1, bm);
                if (__builtin_amdgcn_ballot_w64(mn > m1) != 0ull) {
                    const float alpha = ex2(m1 - mn); l1 *= alpha;
#pragma unroll
                    for (int r = 0; r < 16; ++r) { oc[0][r] *= alpha; oc[1][r] *= alpha; }
                    if (need_imp) {
#pragma unroll
                        for (int i = 0; i < 33; ++i) imp[i] *= alpha;
                    }
                }
                m1 = mn;
                const float c2 = (mn > -1e29f) ? mn - Tb : 1e30f;
                float rs = 0.f;
#pragma unroll
                for (int r = 0; r < 16; ++r) { p[r] = ex2(p[r] - c2); rs += p[r]; }
                l1 += rs;
                if (need_imp) {
#pragma unroll
                    for (int a = 0; a < 4; ++a) {
                        const float sp = 0.5f * p[4 * a + 3], v = p[4 * a] + p[4 * a + 1] + p[4 * a + 2] + sp, rc = __shfl_xor(sp, 32);
                        imp[4 * blk + a] += v + (hi ? rc : 0.f); imp[4 * blk + a + 1] += (hi ? 0.f : rc);
                    }
                }
#pragma unroll
                for (int j2 = 0; j2 < 2; ++j2) {
                    const bf16x8 pb = pack8(p[8 * j2 + 0], p[8 * j2 + 1], p[8 * j2 + 2], p[8 * j2 + 3], p[8 * j2 + 4], p[8 * j2 + 5], p[8 * j2 + 6], p[8 * j2 + 7]);
#pragma unroll
                    for (int d0 = 0; d0 < 2; ++d0) {
                        const LAS unsigned char* vp = L + L_VCT + ((r32 + 32 * d0) * VCSTR + 32 * blk + 16 * j2 + 4 * hi) * 2;
                        const s16x4 lo4 = *(const LAS s16x4*)vp, hi4 = *(const LAS s16x4*)(vp + 16);
                        const bf16x8 a = (bf16x8){lo4[0], lo4[1], lo4[2], lo4[3], hi4[0], hi4[1], hi4[2], hi4[3]};
                        oc[d0] = MFMA32(a, pb, oc[d0]);
                    }
                }
            }
        }
        const float Lt = l1 + __shfl_xor(l1, 32), inv = 1.0f / fmaxf(Lt, 1e-30f), gi = g0 * inv;
        __syncthreads();
#pragma unroll
        for (int k = 0; k < 4; ++k) {
            park[64 * k] = (f32x4){gi * oc[0][4 * k], gi * oc[0][4 * k + 1], gi * oc[0][4 * k + 2], gi * oc[0][4 * k + 3]};
            park[64 * (4 + k)] = (f32x4){gi * oc[1][4 * k], gi * oc[1][4 * k + 1], gi * oc[1][4 * k + 2], gi * oc[1][4 * k + 3]};
        }
        if (need_imp) {
#pragma unroll
            for (int i = 0; i < 32; ++i) imp[i] *= inv;
        }
    }
    const bf16* kvb = A.KV + (size_t)b * SEQ * 768 + g * 64;
    const bf16* vts = A.VT + (size_t)((b * 2 + 0) * 2 + g) * 64 * SEQ; const bf16* vtw = A.VT + (size_t)((b * 2 + 1) * 2 + g) * 64 * SEQ;
    const v4u ks0 = *(const v4u*)(kvb + 256 + (size_t)(64 * cur + (tid >> 3)) * 768 + (tid & 7) * 8), vs0 = *(const v4u*)(vts + (size_t)(tid >> 3) * SEQ + 64 * cur + (tid & 7) * 8);
    const unsigned long long causal = (cur >= 63) ? ~0ull : ((2ull << cur) - 1ull);
    unsigned long long lmask = causal, umask = causal;
    if (cur >= 16) {
#pragma unroll
        for (int i = 0; i < 32; ++i) { imp[i] += __shfl_xor(imp[i], 1); imp[i] += __shfl_xor(imp[i], 2); }
        if (head == 0) {
            LAS unsigned* sc = (LAS unsigned*)(L + L_SC) + tokl * 64 + hi;
#pragma unroll
            for (int i = 0; i < 32; ++i) { const int jj = 2 * i + hi; const bool forced = (jj == 0) || (jj == cur) || (jj == cur - 1);
                const unsigned kb = forced ? __float_as_uint(1e4f) : ((jj <= cur) ? __float_as_uint(imp[i]) : 0u); sc[2 * i] = (kb & ~63u) | (unsigned)(63 - jj); }
        }
        __syncthreads();
        {
            const int tok = tid >> 3, part = tid & 7; const LAS unsigned* row = (const LAS unsigned*)(L + L_SC) + tok * 64;
            unsigned mine[8]; int rank[8];
#pragma unroll
            for (int e = 0; e < 8; ++e) { mine[e] = row[part * 8 + e]; rank[e] = 0; }
            for (int jj = 0; jj <= cur; jj += 4) {
                const v4u k4 = *(const LAS v4u*)(row + jj);
#pragma unroll
                for (int q = 0; q < 4; ++q) {
#pragma unroll
                    for (int e = 0; e < 8; ++e) rank[e] += (k4[q] > mine[e]) ? 1 : 0;
                }
            }
            unsigned bits = 0u;
#pragma unroll
            for (int e = 0; e < 8; ++e) bits |= (rank[e] < 16 ? 1u : 0u) << e;
            ((LAS unsigned char*)(L + L_MB))[tok * 8 + part] = (unsigned char)bits;
        }
        __syncthreads();
        const v2u mw = *(const LAS v2u*)(L + L_MB + tokl * 8);
        lmask = (((unsigned long long)mw.y << 32) | mw.x) & causal;
        v2u uw = *(const LAS v2u*)(L + L_MB + lane * 8);
#pragma unroll
        for (int o_ = 1; o_ < 64; o_ <<= 1) { uw.x |= (unsigned)__shfl_xor((int)uw.x, o_); uw.y |= (unsigned)__shfl_xor((int)uw.y, o_); }
        umask = ((((unsigned long long)(unsigned)__builtin_amdgcn_readfirstlane((int)uw.y)) << 32) | (unsigned)__builtin_amdgcn_readfirstlane((int)uw.x)) & causal;
    }
    v4u kw0, vw0;
    {
        f32x16 o[2]; float lt;
        attn_branch<false>(L, kvb + 256, vts, umask, lmask, cur, tokl, slope2, cinit, qf, o, lt, tid, r32, hi, false, ks0, vs0);
        kw0 = *(const v4u*)(kvb + 512 + (size_t)(64 * cur + (tid >> 3)) * 768 + (tid & 7) * 8); vw0 = *(const v4u*)(vtw + (size_t)(tid >> 3) * SEQ + 64 * cur + (tid & 7) * 8);
        const float sc = g1 / lt;
#pragma unroll
        for (int k = 0; k < 4; ++k) {
            park[64 * k] += (f32x4){sc * o[0][4 * k], sc * o[0][4 * k + 1], sc * o[0][4 * k + 2], sc * o[0][4 * k + 3]};
            park[64 * (4 + k)] += (f32x4){sc * o[1][4 * k], sc * o[1][4 * k + 1], sc * o[1][4 * k + 2], sc * o[1][4 * k + 3]};
        }
    }
    {
        const int jlo = (cur >= 8) ? cur - 8 : 0;
        const unsigned long long wmask = causal & ~((1ull << jlo) - 1ull);
        f32x16 o[2]; float lt;
                attn_branch<true>(L, kvb + 512, vtw, wmask, ~0ull, cur, tokl, slope2, cinit, qf, o, lt, tid, r32, hi, false, kw0, vw0);
        const float sc = g2 / lt;
        bf16* op = A.O + mrow * 1536 + hq * 64 + 4 * hi;
#pragma unroll
        for (int d0 = 0; d0 < 2; ++d0)
#pragma unroll
            for (int a = 0; a < 4; ++a) {
                const f32x4 pv = park[64 * (4 * d0 + a)];
                v2u wv; wv.x = pk2(pv[0] + sc * o[d0][4 * a], pv[1] + sc * o[d0][4 * a + 1]); wv.y = pk2(pv[2] + sc * o[d0][4 * a + 2], pv[3] + sc * o[d0][4 * a + 3]);
                *(v2u*)(op + 32 * d0 + 8 * a) = wv;
            }
    }
}

__global__ void __launch_bounds__(NWAVES * 64, 2) nsa_block_fwd(Args a) {
    extern __shared__ __attribute__((aligned(16))) unsigned char lds_raw[];
    cg::grid_group grid = cg::this_grid();
    LAS unsigned char* lds = (LAS unsigned char*)lds_raw;
    const int tid = threadIdx.x, lane = tid & 63, wave = __builtin_amdgcn_readfirstlane(tid >> 6);
    const int G = gridDim.x, bx = blockIdx.x, vcu = (G % 8 == 0) ? (bx % 8) * (G / 8) + bx / 8 : bx;
    unsigned char* ws = a.ws;
    float* rowss = (float*)(ws + WS_ROWSS);
    bf16 *WIN_t = (bf16*)(ws + WS_WIN), *WAB_t = (bf16*)(ws + WS_WAB), *WO_t = (bf16*)(ws + WS_WO), *WUP_t = (bf16*)(ws + WS_WUP), *WDN_t = (bf16*)(ws + WS_WDN);
    bf16 *WC_t = (bf16*)(ws + WS_WC);
    bf16 *KCN = (bf16*)(ws + WS_KCN), *VCT = (bf16*)(ws + WS_VCT), *VT = (bf16*)(ws + WS_VT);
    bf16 *GN = (bf16*)(ws + WS_GN), *XN = (bf16*)(ws + WS_XN), *QB = (bf16*)(ws + WS_Q), *KVB = (bf16*)(ws + WS_KV), *UB = (bf16*)(ws + WS_U), *CB = (bf16*)(ws + WS_CB);
    bf16 *GA = (bf16*)a.out, *GB = (bf16*)a.out + (size_t)M * 1024, *ZO = (bf16*)(ws + WS_ZO), *MIX = (bf16*)(ws + WS_MIX), *HB = (bf16*)(ws + WS_H);
    const int gw = vcu * NWAVES + wave, NGW = G * NWAVES;
    unsigned* barw = (unsigned*)(ws + WS_BAR);
    for (int u = tid; u < (LDS_BYTES - RING_BYTES) / 4; u += NWAVES * 64) ((LAS unsigned*)(lds + RING_BYTES))[u] = 0u;
    __syncthreads();
    const XcdBarrier xbar = xcd_barrier_post(barw, (volatile LAS unsigned*)(lds + MISC_OFF) + 8);
    if (a.never) grid.sync();

    {
        LAS float* scr = (LAS float*)(lds + wave * 16384);
        constexpr int I_IN = 16 * 201, I_A = 8 * 32, I_B = 16 * 32, I_O = 16 * 32, I_UP = 16 * 128, I_DN = 64 * 32, I_C = 32 * 2;
        constexpr int I_PAD = NPAD - NPROJ, I_Z = M / 4096;
        constexpr int NITEMS = I_IN + I_A + I_B + I_O + I_UP + I_DN + 2 * I_C + I_PAD + I_Z;
        for (int it = gw; it < NITEMS; it += NGW) {
            int r = it;
            if (r < I_IN) { tr_item<true>(a.w_in, 1024, NPROJ, WIN_t, 1024, nullptr, scr, r, lane); continue; } r -= I_IN;
            if (r < I_A) { tr_item<false>(a.w_branch_a, 512, 1024, WAB_t, 1536, nullptr, scr, r, lane); continue; } r -= I_A;
            if (r < I_B) { tr_item<false>(a.w_branch_b, 1024, 1024, WAB_t + 512, 1536, nullptr, scr, r, lane); continue; } r -= I_B;
            if (r < I_O) { tr_item<false>(a.w_out, 1024, 1024, WO_t, 1024, nullptr, scr, r, lane); continue; } r -= I_O;
            if (r < I_UP) { tr_item<false>(a.w_up, 1024, 4096, WUP_t, 1024, a.norm2_g, scr, r, lane); continue; } r -= I_UP;
            if (r < I_DN) { tr_item<false>(a.w_down, 4096, 1024, WDN_t, 4096, nullptr, scr, r, lane); continue; } r -= I_DN;
            if (r < I_C) { tr_item<false>(a.w_cmp_k, 2048, 64, WC_t, 2048, nullptr, scr, r, lane); continue; } r -= I_C;
            if (r < I_C) { tr_item<false>(a.w_cmp_v, 2048, 64, WC_t + 64 * 2048, 2048, nullptr, scr, r, lane); continue; } r -= I_C;
            if (r < I_PAD) { v4u z = (v4u){0u, 0u, 0u, 0u}; v4u* p = (v4u*)(WIN_t + (size_t)(NPROJ + r) * 1024) + lane * 2; p[0] = z; p[1] = z; continue; } r -= I_PAD;
            { f32x4 z = (f32x4){0.f, 0.f, 0.f, 0.f}; f32x4* p = (f32x4*)(rowss + (size_t)r * 4096) + lane;
#pragma unroll
              for (int i = 0; i < 16; ++i) p[64 * i] = z; }
        }
        for (int m = gw; m < M; m += 8 * NGW) {
            const f32x4* gr = (const f32x4*)a.norm1_g + lane;
            f32x4 v[8][4];
#pragma unroll
            for (int q = 0; q < 8; ++q) { const int mm = (m + q * NGW < M) ? m + q * NGW : m; const f32x4* xr = (const f32x4*)(a.x + (size_t)mm * DM) + lane;
#pragma unroll
                for (int j = 0; j < 4; ++j) v[q][j] = __builtin_nontemporal_load(xr + 64 * j); }
#pragma unroll
            for (int q = 0; q < 8; ++q) {
                float sq = 0.f;
#pragma unroll
                for (int j = 0; j < 4; ++j) sq += (v[q][j].x * v[q][j].x + v[q][j].y * v[q][j].y) + (v[q][j].z * v[q][j].z + v[q][j].w * v[q][j].w);
                const float rstd = __builtin_amdgcn_rsqf(wave_sum(sq) * (1.f / DM) + EPS);
                if (m + q * NGW < M) {
                    v2u* o8 = (v2u*)(XN + (size_t)(m + q * NGW) * DM) + lane;
#pragma unroll
                    for (int j = 0; j < 4; ++j) { const f32x4 gg = gr[64 * j]; v2u wv; wv.x = pk2(v[q][j].x * rstd * gg.x, v[q][j].y * rstd * gg.y); wv.y = pk2(v[q][j].z * rstd * gg.z, v[q][j].w * rstd * gg.w); o8[64 * j] = wv; }
                }
            }
        }
    }
    xcd_barrier(xbar);

    {
        pg8::Gemm g{XN, WIN_t, M, NPAD, 1024}; pg8::StaticOrder S; S.init(M, NPAD, G, bx);
        pg8::EpiProj E{QB, KVB, UB, CB, GA, GB, GN, VT};
        pg8::gemm_phase<pg8::EpiProj, pg8::StaticOrder, true, true>(lds, g, S, E);
    }
    xcd_barrier(xbar);

    {
        const int r32 = lane & 31, hi = lane >> 5;
        const int e0 = (lane & 7) * 8;
        float kgv[8];
#pragma unroll
        for (int e = 0; e < 8; ++e) kgv[e] = a.k_norm_g[64 * (1 + ((lane >> 4) & 1)) + e0 + e];
        for (int rb = gw; rb < M / 16; rb += NGW) {
            const int m0 = rb * 16, tt0 = m0 & (SEQ - 1), bb = m0 / SEQ;
            const int kcol = (((lane >> 4) & 1) ? 512 : 256) + (lane & 15) * 8;
#pragma unroll 1
            for (int k4 = 0; k4 < 16; k4 += 4) {
                v4u kw[4];
#pragma unroll
                for (int i = 0; i < 4; ++i) { kw[i] = (v4u){0u, 0u, 0u, 0u}; if (lane < 32) kw[i] = *(const v4u*)(KVB + (size_t)(m0 + k4 + i) * 768 + kcol); }
#pragma unroll
                for (int i = 0; i < 4; ++i) {
                    const v4u w = kw[i];
                    float f[8] = {blo(w.x), bhi(w.x), blo(w.y), bhi(w.y), blo(w.z), bhi(w.z), blo(w.w), bhi(w.w)};
                    float ss = 0.f;
#pragma unroll
                    for (int e = 0; e < 8; ++e) ss += f[e] * f[e];
                    ss += __shfl_xor(ss, 1); ss += __shfl_xor(ss, 2); ss += __shfl_xor(ss, 4);
                    const float rstd = __builtin_amdgcn_rsqf(ss * (1.f / 64.f) + EPS);
                    v4u o; o.x = pk2(f[0] * rstd * kgv[0], f[1] * rstd * kgv[1]); o.y = pk2(f[2] * rstd * kgv[2], f[3] * rstd * kgv[3]); o.z = pk2(f[4] * rstd * kgv[4], f[5] * rstd * kgv[5]); o.w = pk2(f[6] * rstd * kgv[6], f[7] * rstd * kgv[7]);
                    if (lane < 32) *(v4u*)(KVB + (size_t)(m0 + k4 + i) * 768 + kcol) = o;
                }
            }
#pragma unroll 1
            for (int h = 0; h < 2; ++h) {
                const int ch = (h * 64 + lane) * 8;
                const f32x4 wa0 = *(const f32x4*)(a.conv_w + ch), wa1 = *(const f32x4*)(a.conv_w + ch + 4);
                const f32x4 wb0 = *(const f32x4*)(a.conv_w + 1024 + ch), wb1 = *(const f32x4*)(a.conv_w + 1024 + ch + 4);
                const f32x4 wc0 = *(const f32x4*)(a.conv_w + 2048 + ch), wc1 = *(const f32x4*)(a.conv_w + 2048 + ch + 4);
                v4u u1 = (v4u){0u, 0u, 0u, 0u}, u2 = (v4u){0u, 0u, 0u, 0u};
                if (tt0 != 0) { u1 = *(const v4u*)(UB + (size_t)(m0 - 1) * 1024 + ch); u2 = *(const v4u*)(UB + (size_t)(m0 - 2) * 1024 + ch); }
#pragma unroll 1
                for (int k4 = 0; k4 < 16; k4 += 4) {
                    v4u uu[4], cbv[4];
#pragma unroll
                    for (int i = 0; i < 4; ++i) { uu[i] = *(const v4u*)(UB + (size_t)(m0 + k4 + i) * 1024 + ch); cbv[i] = *(const v4u*)(CB + (size_t)(m0 + k4 + i) * 1024 + ch); }
#pragma unroll
                    for (int i = 0; i < 4; ++i) {
                        const v4u u0 = uu[i], cb = cbv[i]; v4u o;
                        o.x = pk2(blo(cb.x) * (wa0[0] * blo(u2.x) + wb0[0] * blo(u1.x) + wc0[0] * blo(u0.x)), bhi(cb.x) * (wa0[1] * bhi(u2.x) + wb0[1] * bhi(u1.x) + wc0[1] * bhi(u0.x)));
                        o.y = pk2(blo(cb.y) * (wa0[2] * blo(u2.y) + wb0[2] * blo(u1.y) + wc0[2] * blo(u0.y)), bhi(cb.y) * (wa0[3] * bhi(u2.y) + wb0[3] * bhi(u1.y) + wc0[3] * bhi(u0.y)));
                        o.z = pk2(blo(cb.z) * (wa1[0] * blo(u2.z) + wb1[0] * blo(u1.z) + wc1[0] * blo(u0.z)), bhi(cb.z) * (wa1[1] * bhi(u2.z) + wb1[1] * bhi(u1.z) + wc1[1] * bhi(u0.z)));
                        o.w = pk2(blo(cb.w) * (wa1[2] * blo(u2.w) + wb1[2] * blo(u1.w) + wc1[2] * blo(u0.w)), bhi(cb.w) * (wa1[3] * bhi(u2.w) + wb1[3] * bhi(u1.w) + wc1[3] * bhi(u0.w)));
                        *(v4u*)(ZO + (size_t)(m0 + k4 + i) * 1536 + 512 + ch) = o;
                        u2 = u1; u1 = u0;
                    }
                }
            }
        }
        for (int task = vcu; task < 256; task += G) {
            const int mat = task >> 7, rt = task & 127;
            const int R = rt * 32 + r32, bb = R >> 9, cc = (R >> 1) & 255, gg = R & 1;
            const bf16* abase = KVB + (size_t)(bb * SEQ + 16 * cc) * 768 + mat * 128 + gg * 64 + 8 * hi;
            const float* pos = (mat ? a.cmp_pos_v : a.cmp_pos_k) + 8 * hi;
            const bf16* wb = WC_t + (size_t)mat * (64 * 2048) + (size_t)r32 * 2048 + 8 * hi;
            f32x16 acc0 = f32x16{}, acc1 = f32x16{};
#pragma unroll
            for (int i = 0; i < 16; ++i) {
                const int kk = wave * 16 + i, l = kk >> 2, dd = (kk & 3) * 16;
                const v4u av = *(const v4u*)(abase + (size_t)l * 768 + dd);
                const f32x4 q0 = *(const f32x4*)(pos + l * 64 + dd), q1 = *(const f32x4*)(pos + l * 64 + dd + 4);
                const bf16x8 ap = pack8(blo(av.x) + q0[0], bhi(av.x) + q0[1], blo(av.y) + q0[2], bhi(av.y) + q0[3], blo(av.z) + q1[0], bhi(av.z) + q1[1], blo(av.w) + q1[2], bhi(av.w) + q1[3]);
                const bf16x8 b0 = *(const bf16x8*)(wb + 16 * kk), b1 = *(const bf16x8*)(wb + 32 * 2048 + 16 * kk);
                acc0 = MFMA32(ap, b0, acc0); acc1 = MFMA32(ap, b1, acc1);
            }
            LAS float* red = (LAS float*)lds + wave * 2048;
#pragma unroll
            for (int r = 0; r < 16; ++r) { red[crow(r, hi) * 64 + r32] = acc0[r]; red[crow(r, hi) * 64 + 32 + r32] = acc1[r]; }
            __syncthreads();
            {
                const int row = tid >> 4, c4 = (tid & 15) * 4;
                f32x4 sm = (f32x4){0.f, 0.f, 0.f, 0.f};
#pragma unroll
                for (int w8 = 0; w8 < 8; ++w8) sm += *(const LAS f32x4*)((LAS float*)lds + w8 * 2048 + row * 64 + c4);
                const int R2 = rt * 32 + row, b2 = R2 >> 9, c2 = (R2 >> 1) & 255, g2 = R2 & 1;
                if (c2 == 255) sm = (f32x4){0.f, 0.f, 0.f, 0.f};
                if (mat == 0) {
                    float ss = (sm[0] * sm[0] + sm[1] * sm[1]) + (sm[2] * sm[2] + sm[3] * sm[3]);
                    ss += __shfl_xor(ss, 1); ss += __shfl_xor(ss, 2); ss += __shfl_xor(ss, 4); ss += __shfl_xor(ss, 8);
                    const float rstd = __builtin_amdgcn_rsqf(ss * (1.f / 64.f) + EPS);
                    const f32x4 kg = *(const f32x4*)(a.k_norm_g + c4);
                    v2u o; o.x = pk2(sm[0] * rstd * kg[0], sm[1] * rstd * kg[1]); o.y = pk2(sm[2] * rstd * kg[2], sm[3] * rstd * kg[3]);
                    *(v2u*)(KCN + ((size_t)((b2 * 2 + g2) * 256 + c2)) * 64 + c4) = o;
                } else {
                    bf16* vo = VCT + ((size_t)(b2 * 2 + g2) * 64 + c4) * 256 + c2;
                    const unsigned w0 = pk2(sm[0], sm[1]), w1 = pk2(sm[2], sm[3]);
                    vo[0] = (bf16)(w0 & 0xffffu); vo[256] = (bf16)(w0 >> 16); vo[512] = (bf16)(w1 & 0xffffu); vo[768] = (bf16)(w1 >> 16);
                }
            }
            __syncthreads();
        }
    }
    xcd_barrier(xbar);

    {
        const AttnPtrs A{QB, KVB, GN, KCN, VCT, VT, ZO, a.q_norm_g};
        volatile LAS int* qslot = (volatile LAS int*)(lds + MISC_OFF) + 16;
        unsigned* queue = barw + XCD_BAR_WORDS + 64;
        int idx = bx;
        while (idx < 1024) {
            int nxt = 0;
            if (tid == 0) nxt = (int)atomicAdd(queue, 1u) + G;
            int b_, g_, cur_;
            if (idx < 368) { g_ = 1; cur_ = 63 - (idx >> 3); b_ = idx & 7; }
            else if (idx < 752) { const int r2 = idx - 368; if (r2 < 376) { g_ = 0; cur_ = 63 - (r2 >> 3); b_ = r2 & 7; } else { g_ = 1; cur_ = 17; b_ = r2 - 376; } }
            else { const int r3 = idx - 752; cur_ = 16 - (r3 >> 4); g_ = (r3 >> 3) & 1; b_ = r3 & 7; }
            attn_unit(A, lds, b_, g_, cur_);
            if (tid == 0) qslot[0] = nxt;
            __syncthreads();
            idx = qslot[0];
            __syncthreads();
        }
    }
    xcd_barrier(xbar);

    {
        pg8::Gemm g{ZO, WAB_t, M, 1024, 1536}; pg8::StaticOrder S; S.init(M, 1024, G, bx);
        pg8::EpiMix E{GA, GB, MIX, 1024};
        pg8::gemm_phase<pg8::EpiMix, pg8::StaticOrder, true, true>(lds, g, S, E);
    }
    xcd_barrier(xbar);
    {
        pg8::Gemm g{MIX, WO_t, M, 1024, 1024}; pg8::StaticOrder S; S.init(M, 1024, G, bx);
        pg8::EpiX1 E{a.x, XN, rowss};
        pg8::gemm_phase<pg8::EpiX1, pg8::StaticOrder, true, true>(lds, g, S, E);
    }
    xcd_barrier(xbar);
    {
        pg8::Gemm g{XN, WUP_t, M, DFF, 1024}; pg8::StaticOrder S; S.init(M, DFF, G, bx);
        pg8::EpiUp E{rowss, HB, DFF, {}};
        pg8::gemm_phase<pg8::EpiUp, pg8::StaticOrder, true, true>(lds, g, S, E);
    }
    xcd_barrier(xbar);
    {
        pg8::Gemm g{HB, WDN_t, M, 1024, DFF}; pg8::StaticOrder S; S.init(M, 1024, G, bx);
        pg8::EpiDown E{XN, a.out};
        pg8::gemm_phase<pg8::EpiDown, pg8::StaticOrder, true, true>(lds, g, S, E);
    }
}

extern "C" void kernel_launch(void* const* d_in, const int* in_sizes, int n_in, void* d_out, int out_size, void* d_ws, size_t ws_size, hipStream_t stream) {
    static int grid = 0;
    if (grid == 0) {
        if (n_in != 16 || out_size != M * DM || ws_size < WS_END) { fprintf(stderr, "kernel_launch: unexpected shapes (n_in %d, out %d, ws %zu)\n", n_in, out_size, ws_size); grid = -1; return; }
        int dev = 0, cus = 0, per_cu = 0;
        (void)hipGetDevice(&dev); (void)hipDeviceGetAttribute(&cus, hipDeviceAttributeMultiprocessorCount, dev);
        if (hipFuncSetAttribute((const void*)nsa_block_fwd, hipFuncAttributeMaxDynamicSharedMemorySize, LDS_BYTES) != hipSuccess) { fprintf(stderr, "kernel_launch: hipFuncSetAttribute failed\n"); grid = -1; return; }
        if (hipOccupancyMaxActiveBlocksPerMultiprocessor(&per_cu, (const void*)nsa_block_fwd, NWAVES * 64, LDS_BYTES) != hipSuccess || per_cu < 1) { fprintf(stderr, "kernel_launch: occupancy query says %d\n", per_cu); per_cu = 1; }
        (void)hipGetLastError();
        grid = cus * 1;
    }
    if (grid < 0) return;
    if (hipMemsetAsync((char*)d_ws + WS_BAR, 0, (XCD_BAR_WORDS + 128) * sizeof(unsigned), stream) != hipSuccess) { fprintf(stderr, "kernel_launch: hipMemsetAsync failed\n"); return; }
    Args a{};
    a.x = (const float*)d_in[0]; a.norm1_g = (const float*)d_in[1]; a.w_in = (const float*)d_in[2]; a.q_norm_g = (const float*)d_in[3]; a.k_norm_g = (const float*)d_in[4];
    a.cmp_pos_k = (const float*)d_in[5]; a.cmp_pos_v = (const float*)d_in[6]; a.w_cmp_k = (const float*)d_in[7]; a.w_cmp_v = (const float*)d_in[8]; a.conv_w = (const float*)d_in[9];
    a.w_branch_a = (const float*)d_in[10]; a.w_branch_b = (const float*)d_in[11]; a.w_out = (const float*)d_in[12]; a.norm2_g = (const float*)d_in[13]; a.w_up = (const float*)d_in[14]; a.w_down = (const float*)d_in[15];
    a.out = (float*)d_out; a.ws = (unsigned char*)d_ws;
    void* args[] = {&a};
    hipError_t e = hipLaunchCooperativeKernel((const void*)nsa_block_fwd, dim3(grid), dim3(NWAVES * 64), args, LDS_BYTES, stream);
    if (e != hipSuccess) fprintf(stderr, "kernel_launch: cooperative launch failed: %s (grid %d)\n", hipGetErrorString(e), grid);
}
```

```cpp
#include <hip/hip_runtime.h>
#include <hip/hip_cooperative_groups.h>
#include <cstdio>
#include <cstdint>
namespace cg = cooperative_groups;
namespace pg8 {
#define PG8_LAS __attribute__((address_space(3)))
typedef unsigned short bf16_t;
typedef short bf16x8 __attribute__((ext_vector_type(8)));
typedef float f32x4 __attribute__((ext_vector_type(4)));
typedef unsigned u32x4 __attribute__((ext_vector_type(4)));
constexpr int BM = 256, BK = 64, HALF = 128, HTB = HALF * BK * 2  , STAGE_BYTES = 8 * HTB, NXCD = 8, WGM = 8;

__host__ __device__ __forceinline__ int lds_byte(int r, int c) { const int st = (r >> 4) * 2 + (c >> 5), rr = r & 15, cc = c & 31, ob = rr * 64 + cc * 2; return st * 1024 + (ob ^ (((ob >> 9) & 1) << 5)); }
__host__ __device__ __forceinline__ void stage_rc(int b, int& R, int& C) { const int st = b / 1024, sb = b % 1024, swz = sb ^ (((sb >> 9) & 1) << 5); R = (st >> 1) * 16 + swz / 64; C = (st & 1) * 32 + (swz % 64) / 2; }
__host__ __device__ __forceinline__ int perm32(int rho) { const int n = rho >> 4, i = rho & 15; return 8 * (i >> 2) + 4 * n + (i & 3); }

struct Unit { int pm, pn; };
struct Gemm { const bf16_t* A; const bf16_t* Bt; int M, N, K; };

struct StaticOrder {
    int nM, nN, nwg, G, c;
    __host__ __device__ void init(int M, int N, int G_, int c_) { nM = M / BM; nN = N / BM; nwg = nM * nN; G = G_; c = c_; }
    __host__ __device__ bool next(int i, Unit& u) const {
        const long L = (long)i * G + c; if (L >= nwg) return false;
        int wgid = (int)L; { const int q = nwg / NXCD, r = nwg % NXCD, xcd = wgid % NXCD, off = wgid / NXCD; wgid = (xcd < r ? xcd * (q + 1) : r * (q + 1) + (xcd - r) * q) + off; }
        const int nig = WGM * nN, gid = wgid / nig, fm = gid * WGM, gsz = (nM - fm) < WGM ? (nM - fm) : WGM;
        u.pm = fm + ((wgid % nig) % gsz); u.pn = (wgid % nig) / gsz; return true;
    }
    __device__ __forceinline__ void a_ready(const Unit&) const {}
    __device__ __forceinline__ void done(const Unit&) const {}
};

typedef float pg8_f32x2_t __attribute__((ext_vector_type(2))); typedef __bf16 pg8_bf16x2_t __attribute__((ext_vector_type(2)));
__device__ __forceinline__ unsigned cvt_pk_bf16(float lo, float hi) { pg8_f32x2_t v = {lo, hi}; pg8_bf16x2_t b = __builtin_convertvector(v, pg8_bf16x2_t); return __builtin_bit_cast(unsigned, b); }
typedef float f32x2 __attribute__((ext_vector_type(2)));
typedef unsigned u32x2 __attribute__((ext_vector_type(2)));
__device__ __forceinline__ float bflo(unsigned w) { return __uint_as_float(w << 16); }
__device__ __forceinline__ float bfhi(unsigned w) { return __uint_as_float(w & 0xffff0000u); }
__device__ __forceinline__ float sigm(float x) { return __builtin_amdgcn_rcpf(1.f + __expf(-x)); }

struct EpiProj {
    static constexpr bool PERM = true, AFTER_DRAIN = false; static constexpr int MID_T = 0; static constexpr bool HAS_PRE = false;
    bf16_t *Q, *KV, *U, *CB, *GA, *GB, *GN, *VT;
    static __device__ __forceinline__ u32x4 pack(const f32x4& v0, const f32x4& v1) { u32x4 w; w.x = cvt_pk_bf16(v0[0], v0[1]); w.y = cvt_pk_bf16(v0[2], v0[3]); w.z = cvt_pk_bf16(v1[0], v1[1]); w.w = cvt_pk_bf16(v1[2], v1[3]); return w; }
    __device__ __forceinline__ void plain(const f32x4 (&acc)[2][2][4][2], bf16_t* base, int ldc, int row0, int col0) const {
#pragma unroll
        for (int ai = 0; ai < 2; ++ai)
#pragma unroll
            for (int m = 0; m < 4; ++m) {
                bf16_t* rowp = base + (size_t)(row0 + ai * HALF + m * 16) * ldc + col0;
#pragma unroll
                for (int bj = 0; bj < 2; ++bj) *(u32x4*)(rowp + bj * HALF) = pack(acc[ai][bj][m][0], acc[ai][bj][m][1]);
            }
    }
    __device__ __forceinline__ void operator()(const f32x4 (&acc)[2][2][4][2], const Unit& u, int wr, int wc, int fr, int fq) const {
        const int pn = u.pn, row0 = u.pm * BM + wr * 64 + fr, cw = wc * 32 + 8 * fq;
        if (pn < 2) {
#pragma unroll
            for (int ai = 0; ai < 2; ++ai)
#pragma unroll
                for (int m = 0; m < 4; ++m)
#pragma unroll
                    for (int bj = 0; bj < 2; ++bj) __builtin_nontemporal_store(pack(acc[ai][bj][m][0], acc[ai][bj][m][1]), (u32x4*)(Q + (size_t)(row0 + ai * HALF + m * 16) * 512 + pn * 256 + cw + bj * HALF));
        }
        else if (pn == 2) plain(acc, KV, 768, row0, cw);
        else if (pn < 5) {
#pragma unroll
            for (int ai = 0; ai < 2; ++ai)
#pragma unroll
                for (int m = 0; m < 4; ++m) {
                    const int row = row0 + ai * HALF + m * 16;
                    *(u32x4*)(KV + (size_t)row * 768 + (pn - 2) * 256 + cw) = pack(acc[ai][0][m][0], acc[ai][0][m][1]);
                    const u32x4 w = pack(acc[ai][1][m][0], acc[ai][1][m][1]);
                    bf16_t* vt = VT + ((size_t)((((row >> 12) * 2 + (pn - 3)) * 2 + (wc >> 1)) * 64 + (wc & 1) * 32 + 8 * fq)) * 4096 + (row & 4095);
                    vt[0 * 4096] = (bf16_t)(w.x & 0xffffu); vt[1 * 4096] = (bf16_t)(w.x >> 16); vt[2 * 4096] = (bf16_t)(w.y & 0xffffu); vt[3 * 4096] = (bf16_t)(w.y >> 16);
                    vt[4 * 4096] = (bf16_t)(w.z & 0xffffu); vt[5 * 4096] = (bf16_t)(w.z >> 16); vt[6 * 4096] = (bf16_t)(w.w & 0xffffu); vt[7 * 4096] = (bf16_t)(w.w >> 16);
                }
        } else if (pn < 13) {
#pragma unroll
            for (int ai = 0; ai < 2; ++ai)
#pragma unroll
                for (int m = 0; m < 4; ++m)
                    *(u32x4*)(U + (size_t)(row0 + ai * HALF + m * 16) * 1024 + (pn - 5) * 128 + cw) = pack(acc[ai][0][m][0] * acc[ai][1][m][0], acc[ai][0][m][1] * acc[ai][1][m][1]);
        } else if (pn < 17) plain(acc, CB, 1024, row0, (pn - 13) * 256 + cw);
        else if (pn < 25) {
#pragma unroll
            for (int ai = 0; ai < 2; ++ai)
#pragma unroll
                for (int m = 0; m < 4; ++m) {
                    f32x4 a0 = acc[ai][0][m][0], a1 = acc[ai][0][m][1], b0 = acc[ai][1][m][0], b1 = acc[ai][1][m][1];
#pragma unroll
                    for (int i = 0; i < 4; ++i) { b0[i] = sigm(b0[i]); b1[i] = sigm(b1[i]); a0[i] = sigm(a0[i]) * __builtin_amdgcn_rcpf(b0[i]); a1[i] = sigm(a1[i]) * __builtin_amdgcn_rcpf(b1[i]); }
                    const size_t off = (size_t)(row0 + ai * HALF + m * 16) * 1024 + (pn - 17) * 128 + cw;
                    __builtin_nontemporal_store(pack(a0, a1), (u32x4*)(GA + off)); __builtin_nontemporal_store(pack(b0, b1), (u32x4*)(GB + off));
                }
        } else if (wc == 0) {
#pragma unroll
            for (int ai = 0; ai < 2; ++ai)
#pragma unroll
                for (int m = 0; m < 4; ++m) {
                    f32x4 v0 = acc[ai][0][m][0], v1 = acc[ai][0][m][1];
#pragma unroll
                    for (int i = 0; i < 4; ++i) { v0[i] = sigm(v0[i]); v1[i] = sigm(v1[i]); }
                    *(u32x4*)(GN + (size_t)(row0 + ai * HALF + m * 16) * 32 + 8 * fq) = pack(v0, v1);
                }
        }
    }
};
struct EpiMix {
    static constexpr bool PERM = true, AFTER_DRAIN = false; static constexpr int MID_T = 8; static constexpr bool HAS_PRE = false;
    const bf16_t* GA; const bf16_t* GB; bf16_t* O; int ldc;
    __device__ __forceinline__ void mid(f32x4 (&acc)[2][2][4][2], const Unit& u, int wr, int wc, int fr, int fq) const {
        int row0 = u.pm * BM + wr * 64 + fr, col0 = u.pn * BM + wc * 32 + 8 * fq;
        asm volatile("" : "+v"(row0), "+v"(col0));
#pragma unroll
        for (int ai = 0; ai < 2; ++ai)
#pragma unroll
            for (int m = 0; m < 4; ++m)
#pragma unroll
                for (int bj = 0; bj < 2; ++bj) {
                    const size_t off = (size_t)(row0 + ai * HALF + m * 16) * ldc + col0 + bj * HALF;
                    const u32x4 a = *(const u32x4*)(GA + off);
                    acc[ai][bj][m][0] *= (f32x4){bflo(a.x), bfhi(a.x), bflo(a.y), bfhi(a.y)}; acc[ai][bj][m][1] *= (f32x4){bflo(a.z), bfhi(a.z), bflo(a.w), bfhi(a.w)};
                }
    }
    __device__ __forceinline__ void operator()(const f32x4 (&acc)[2][2][4][2], const Unit& u, int wr, int wc, int fr, int fq) const {
        const int row0 = u.pm * BM + wr * 64 + fr, col0 = u.pn * BM + wc * 32 + 8 * fq;
        u32x4 g[2][4][2];
#pragma unroll
        for (int ai = 0; ai < 2; ++ai)
#pragma unroll
            for (int m = 0; m < 4; ++m)
#pragma unroll
                for (int bj = 0; bj < 2; ++bj) g[ai][m][bj] = *(const u32x4*)(GB + (size_t)(row0 + ai * HALF + m * 16) * ldc + col0 + bj * HALF);
#pragma unroll
        for (int ai = 0; ai < 2; ++ai)
#pragma unroll
            for (int m = 0; m < 4; ++m)
#pragma unroll
                for (int bj = 0; bj < 2; ++bj) {
                    const size_t off = (size_t)(row0 + ai * HALF + m * 16) * ldc + col0 + bj * HALF;
                    const u32x4 gg = g[ai][m][bj];
                    const f32x4 v0 = acc[ai][bj][m][0], v1 = acc[ai][bj][m][1];
                    u32x4 w;
                    w.x = cvt_pk_bf16(bflo(gg.x) * v0[0], bfhi(gg.x) * v0[1]);
                    w.y = cvt_pk_bf16(bflo(gg.y) * v0[2], bfhi(gg.y) * v0[3]);
                    w.z = cvt_pk_bf16(bflo(gg.z) * v1[0], bfhi(gg.z) * v1[1]);
                    w.w = cvt_pk_bf16(bflo(gg.w) * v1[2], bfhi(gg.w) * v1[3]);
                    *(u32x4*)(O + off) = w;
                }
    }
};
struct EpiX1 {
    static constexpr bool PERM = false, AFTER_DRAIN = false; static constexpr int MID_T = 0; static constexpr bool HAS_PRE = false;
    const float* x; bf16_t* xb; float* rowss;
    __device__ __forceinline__ void operator()(const f32x4 (&acc)[2][2][4][2], const Unit& u, int wr, int wc, int fr, int fq) const {
        const int row0 = u.pm * BM + wr * 64 + fr, col0 = u.pn * BM + wc * 32 + 4 * fq;
        f32x4 xa[2][2][2], xb_[2][2][2];
#define X1_LOAD(dst, g) do { _Pragma("unroll") for (int mm = 0; mm < 2; ++mm) _Pragma("unroll") for (int bj = 0; bj < 2; ++bj) _Pragma("unroll") for (int n = 0; n < 2; ++n) \
            dst[mm][bj][n] = *(const f32x4*)(x + (size_t)(row0 + ((g) >> 1) * HALF + (2 * ((g) & 1) + mm) * 16) * 1024 + col0 + bj * HALF + n * 16); } while (0)
#define X1_STORE(src, g) do { _Pragma("unroll") for (int mm = 0; mm < 2; ++mm) { const int ai = (g) >> 1, m = 2 * ((g) & 1) + mm, row = row0 + ai * HALF + m * 16; float ss = 0.f; \
            _Pragma("unroll") for (int bj = 0; bj < 2; ++bj) _Pragma("unroll") for (int n = 0; n < 2; ++n) { const size_t off = (size_t)row * 1024 + col0 + bj * HALF + n * 16; \
                const f32x4 vv = src[mm][bj][n] + acc[ai][bj][m][n]; ss += (vv[0] * vv[0] + vv[1] * vv[1]) + (vv[2] * vv[2] + vv[3] * vv[3]); \
                u32x2 w; w.x = cvt_pk_bf16(vv[0], vv[1]); w.y = cvt_pk_bf16(vv[2], vv[3]); *(u32x2*)(xb + off) = w; } \
            ss += __shfl_xor(ss, 16); ss += __shfl_xor(ss, 32); if (fq == 0) atomicAdd(rowss + row, ss); } } while (0)
        X1_LOAD(xa, 0); X1_LOAD(xb_, 1);
        X1_STORE(xa, 0); X1_LOAD(xa, 2);
        X1_STORE(xb_, 1); X1_LOAD(xb_, 3);
        X1_STORE(xa, 2);
        X1_STORE(xb_, 3);
#undef X1_LOAD
#undef X1_STORE
    }
};
struct EpiUp {
    static constexpr bool PERM = true, AFTER_DRAIN = false; static constexpr int MID_T = 0; static constexpr bool HAS_PRE = true;
    const float* rowss; bf16_t* H; int ldc;
    mutable float rsv[2][4];
    __device__ __forceinline__ void pre(const Unit& u, int wr, int fr) const {
        const int row0 = u.pm * BM + wr * 64 + fr;
#pragma unroll
        for (int ai = 0; ai < 2; ++ai)
#pragma unroll
            for (int m = 0; m < 4; ++m) rsv[ai][m] = rowss[row0 + ai * HALF + m * 16];
    }
    __device__ __forceinline__ void operator()(const f32x4 (&acc)[2][2][4][2], const Unit& u, int wr, int wc, int fr, int fq) const {
        const int row0 = u.pm * BM + wr * 64 + fr, col0 = u.pn * BM + wc * 32 + 8 * fq;
#pragma unroll
        for (int ai = 0; ai < 2; ++ai)
#pragma unroll
            for (int m = 0; m < 4; ++m) {
                const int row = row0 + ai * HALF + m * 16;
                const float rs = __builtin_amdgcn_rsqf(rsv[ai][m] * (1.0f / 1024.0f) + 1e-6f);
#pragma unroll
                for (int bj = 0; bj < 2; ++bj) {
                    f32x4 v0 = acc[ai][bj][m][0] * rs, v1 = acc[ai][bj][m][1] * rs;
#pragma unroll
                    for (int i = 0; i < 4; ++i) { const float a = fmaxf(v0[i], 0.f), b = fmaxf(v1[i], 0.f); v0[i] = a * a; v1[i] = b * b; }
                    u32x4 w; w.x = cvt_pk_bf16(v0[0], v0[1]); w.y = cvt_pk_bf16(v0[2], v0[3]); w.z = cvt_pk_bf16(v1[0], v1[1]); w.w = cvt_pk_bf16(v1[2], v1[3]);
                    *(u32x4*)(H + (size_t)row * ldc + col0 + bj * HALF) = w;
                }
            }
    }
};
struct EpiDown {
    static constexpr bool PERM = false, AFTER_DRAIN = false; static constexpr int MID_T = 0; static constexpr bool HAS_PRE = false;
    const bf16_t* xb; float* out;
    __device__ __forceinline__ void operator()(const f32x4 (&acc)[2][2][4][2], const Unit& u, int wr, int wc, int fr, int fq) const {
        const int row0 = u.pm * BM + wr * 64 + fr, col0 = u.pn * BM + wc * 32 + 4 * fq;
        u32x2 xr[2][4][2][2];
#pragma unroll
        for (int ai = 0; ai < 2; ++ai)
#pragma unroll
            for (int m = 0; m < 4; ++m)
#pragma unroll
                for (int bj = 0; bj < 2; ++bj)
#pragma unroll
                    for (int n = 0; n < 2; ++n) xr[ai][m][bj][n] = *(const u32x2*)(xb + (size_t)(row0 + ai * HALF + m * 16) * 1024 + col0 + bj * HALF + n * 16);
#pragma unroll
        for (int ai = 0; ai < 2; ++ai)
#pragma unroll
            for (int m = 0; m < 4; ++m)
#pragma unroll
                for (int bj = 0; bj < 2; ++bj)
#pragma unroll
                    for (int n = 0; n < 2; ++n) { const u32x2 xw = xr[ai][m][bj][n];
                        *(f32x4*)(out + (size_t)(row0 + ai * HALF + m * 16) * 1024 + col0 + bj * HALF + n * 16) = (f32x4){bflo(xw.x), bfhi(xw.x), bflo(xw.y), bfhi(xw.y)} + acc[ai][bj][m][n]; }
    }
};
template <class Epi, class Sched, bool ALIGN_EPI = false, bool SP2 = false>
__device__ __forceinline__ void gemm_phase(PG8_LAS unsigned char* lds, const Gemm g, const Sched& S, const Epi& E) {
    int tid_ = threadIdx.x; asm volatile("" : "+v"(tid_));
    const int tid = tid_, wid = __builtin_amdgcn_readfirstlane(tid >> 6), lane = tid & 63, wr = wid >> 2, wc = wid & 3, fr = lane & 15, fq = lane >> 4;
    const int K = g.K, nt = K / BK;
    unsigned voffA[2], voffB[2];
#pragma unroll
    for (int i = 0; i < 2; ++i) { int R, C; stage_rc(tid * 16 + i * 8192, R, C); const int Rb = Epi::PERM ? ((R & ~31) + perm32(R & 31)) : R;
        voffA[i] = (unsigned)(R * K + C) * 2u; voffB[i] = (unsigned)(Rb * K + C) * 2u; }
    const size_t kstep = (size_t)(BK * 2);
    const size_t hstep = (size_t)HALF * K * 2;
    const size_t tstep = 2 * hstep;
    const unsigned ldsw = (unsigned)wid * 1024u;
    const int aoff = lds_byte(wr * 64 + fr, fq * 8), boff = lds_byte(wc * 32 + fr, fq * 8);
#define PG8_SA(b, h) (((b) * 2 + (h)) * HTB)
#define PG8_SB(b, h) ((4 + (b) * 2 + (h)) * HTB)
#define PG8_STAGE(bufoff, gbase, voff) do { _Pragma("unroll") for (int _i = 0; _i < 2; ++_i) \
        __builtin_amdgcn_global_load_lds((const unsigned*)((const char*)(gbase) + (voff)[_i]), (PG8_LAS unsigned*)(lds + (bufoff) + ldsw + _i * 8192), 16, 0, 0); } while (0)
#define PG8_LDA(dst, b, h) do { _Pragma("unroll") for (int m = 0; m < 4; ++m) _Pragma("unroll") for (int k = 0; k < 2; ++k) dst[m][k] = *(const PG8_LAS bf16x8*)(lds + PG8_SA(b, h) + aoff + m * 2048 + k * 1024); } while (0)
#define PG8_LDB(dst, b, h) do { _Pragma("unroll") for (int n = 0; n < 2; ++n) _Pragma("unroll") for (int k = 0; k < 2; ++k) dst[n][k] = *(const PG8_LAS bf16x8*)(lds + PG8_SB(b, h) + boff + n * 2048 + k * 1024); } while (0)
#define PG8_MMA(ai, bj, At, Bt) do { __builtin_amdgcn_s_setprio(1); _Pragma("unroll") for (int m = 0; m < 4; ++m) _Pragma("unroll") for (int n = 0; n < 2; ++n) _Pragma("unroll") for (int k = 0; k < 2; ++k) \
        acc[ai][bj][m][n] = __builtin_amdgcn_mfma_f32_16x16x32_bf16(Bt[n][k], At[m][k], acc[ai][bj][m][n], 0, 0, 0); __builtin_amdgcn_s_setprio(0); } while (0)
#define PG8_WAIT_V(n) asm volatile("s_waitcnt vmcnt(" #n ")" ::: "memory")
#define PG8_WAIT_L(n) asm volatile("s_waitcnt lgkmcnt(" #n ")" ::: "memory")
#define PG8_BAR __builtin_amdgcn_s_barrier()
#define PG8_SCHED __builtin_amdgcn_sched_barrier(0)
    Unit cur, nxt; int ui = 0;
    if (!S.next(0, cur)) return;
    f32x4 acc[2][2][4][2];
#pragma unroll
    for (int a = 0; a < 2; ++a)
#pragma unroll
        for (int b = 0; b < 2; ++b)
#pragma unroll
            for (int m = 0; m < 4; ++m)
#pragma unroll
                for (int n = 0; n < 2; ++n) acc[a][b][m][n] = (f32x4){0.f, 0.f, 0.f, 0.f};
    bf16x8 At[4][2], B0[2][2], B1[2][2];
    const char* cA = (const char*)g.A + (size_t)cur.pm * tstep; const char* cB = (const char*)g.Bt + (size_t)cur.pn * tstep;
    S.a_ready(cur);
    if constexpr (SP2) {
        PG8_STAGE(PG8_SB(0, 0), cB, voffB); PG8_STAGE(PG8_SB(0, 1), cB + hstep, voffB); PG8_STAGE(PG8_SA(0, 0), cA, voffA); PG8_STAGE(PG8_SA(0, 1), cA + hstep, voffA);
        if (wr == 1) PG8_BAR;
        PG8_WAIT_V(2); PG8_BAR;
        PG8_STAGE(PG8_SB(1, 0), cB + kstep, voffB); PG8_STAGE(PG8_SA(1, 0), cA + kstep, voffA); PG8_STAGE(PG8_SB(1, 1), cB + hstep + kstep, voffB);
        PG8_WAIT_V(6); PG8_BAR;
    } else {
        PG8_STAGE(PG8_SB(0, 0), cB, voffB); PG8_STAGE(PG8_SA(0, 0), cA, voffA); PG8_STAGE(PG8_SB(0, 1), cB + hstep, voffB); PG8_STAGE(PG8_SA(0, 1), cA + hstep, voffA);
        if (wr == 1) PG8_BAR;
        PG8_WAIT_V(4); PG8_BAR;
        PG8_STAGE(PG8_SB(1, 0), cB + kstep, voffB); PG8_STAGE(PG8_SA(1, 0), cA + kstep, voffA); PG8_STAGE(PG8_SB(1, 1), cB + hstep + kstep, voffB);
        PG8_WAIT_V(6); PG8_BAR;
    }
    for (;;) {
        const bool has_next = S.next(ui + 1, nxt);
        const char* nA = has_next ? (const char*)g.A + (size_t)nxt.pm * tstep : cA; const char* nB = has_next ? (const char*)g.Bt + (size_t)nxt.pn * tstep : cB;
        for (int t = 0; t < nt; t += 2) {
            if constexpr (Epi::MID_T > 0) { if (t == Epi::MID_T) E.mid(acc, cur, wr, wc, fr, fq); }
            const bool last = (t == nt - 2);
            const char* a1 = cA + (size_t)(t + 1) * kstep;
            const char* a2 = last ? nA : cA + (size_t)(t + 2) * kstep; const char* b2 = last ? nB : cB + (size_t)(t + 2) * kstep;
            const char* a3 = a2 + kstep; const char* b3 = b2 + kstep;
            if (last && has_next) S.a_ready(nxt);
            if constexpr (Epi::HAS_PRE) { if (last) E.pre(cur, wr, fr); }
            if constexpr (SP2) {
            PG8_LDB(B0, 0, 0); PG8_LDB(B1, 0, 1); PG8_SCHED; PG8_LDA(At, 0, 0); PG8_STAGE(PG8_SA(1, 1), a1 + hstep, voffA);
            PG8_WAIT_V(8); PG8_WAIT_L(0); PG8_BAR; PG8_MMA(0, 0, At, B0); PG8_MMA(0, 1, At, B1); PG8_BAR; PG8_SCHED;
            PG8_LDA(At, 0, 1); PG8_STAGE(PG8_SB(0, 0), b2, voffB); PG8_STAGE(PG8_SB(0, 1), b2 + hstep, voffB); PG8_STAGE(PG8_SA(0, 0), a2, voffA);
            PG8_WAIT_V(8); PG8_WAIT_L(0); PG8_BAR; PG8_MMA(1, 0, At, B0); PG8_MMA(1, 1, At, B1); PG8_BAR; PG8_SCHED;
            PG8_LDB(B0, 1, 0); PG8_LDB(B1, 1, 1); PG8_SCHED; PG8_LDA(At, 1, 0); PG8_STAGE(PG8_SA(0, 1), a2 + hstep, voffA);
            PG8_WAIT_V(8); PG8_WAIT_L(0); PG8_BAR; PG8_MMA(0, 0, At, B0); PG8_MMA(0, 1, At, B1); PG8_BAR; PG8_SCHED;
            PG8_LDA(At, 1, 1); PG8_STAGE(PG8_SB(1, 0), b3, voffB); PG8_STAGE(PG8_SB(1, 1), b3 + hstep, voffB); PG8_STAGE(PG8_SA(1, 0), a3, voffA);
            PG8_WAIT_V(8); PG8_WAIT_L(0); PG8_BAR; PG8_MMA(1, 0, At, B0); PG8_MMA(1, 1, At, B1); PG8_BAR; PG8_SCHED;
            } else {
            PG8_LDB(B0, 0, 0); PG8_SCHED; PG8_LDA(At, 0, 0); PG8_STAGE(PG8_SA(1, 1), a1 + hstep, voffA);
            PG8_WAIT_L(8); PG8_BAR; PG8_WAIT_L(0); PG8_MMA(0, 0, At, B0); PG8_BAR; PG8_SCHED;
            PG8_LDB(B1, 0, 1); PG8_STAGE(PG8_SB(0, 0), b2, voffB);
            PG8_BAR; PG8_WAIT_L(0); PG8_MMA(0, 1, At, B1); PG8_BAR;
            PG8_LDA(At, 0, 1); PG8_STAGE(PG8_SA(0, 0), a2, voffA);
            PG8_BAR; PG8_WAIT_L(0); PG8_MMA(1, 0, At, B0); PG8_BAR; PG8_SCHED;
            PG8_STAGE(PG8_SB(0, 1), b2 + hstep, voffB);
            PG8_WAIT_V(6); PG8_BAR; PG8_MMA(1, 1, At, B1); PG8_BAR;
            PG8_LDB(B0, 1, 0); PG8_SCHED; PG8_LDA(At, 1, 0); PG8_STAGE(PG8_SA(0, 1), a2 + hstep, voffA);
            PG8_WAIT_L(8); PG8_BAR; PG8_WAIT_L(0); PG8_MMA(0, 0, At, B0); PG8_BAR; PG8_SCHED;
            PG8_LDB(B1, 1, 1); PG8_STAGE(PG8_SB(1, 0), b3, voffB);
            PG8_BAR; PG8_WAIT_L(0); PG8_MMA(0, 1, At, B1); PG8_BAR;
            PG8_LDA(At, 1, 1); PG8_STAGE(PG8_SA(1, 0), a3, voffA);
            PG8_BAR; PG8_WAIT_L(0); PG8_MMA(1, 0, At, B0); PG8_BAR; PG8_SCHED;
            PG8_STAGE(PG8_SB(1, 1), b3 + hstep, voffB);
            PG8_WAIT_V(6); PG8_BAR; PG8_MMA(1, 1, At, B1); PG8_BAR;
            }
        }
        if constexpr (ALIGN_EPI) { if (wr == 0) PG8_BAR; }
        if constexpr (!Epi::AFTER_DRAIN) { E(acc, cur, wr, wc, fr, fq); S.done(cur); }
        if (!has_next) break;
#pragma unroll
        for (int a = 0; a < 2; ++a)
#pragma unroll
            for (int b = 0; b < 2; ++b)
#pragma unroll
                for (int m = 0; m < 4; ++m)
#pragma unroll
                    for (int n = 0; n < 2; ++n) acc[a][b][m][n] = (f32x4){0.f, 0.f, 0.f, 0.f};
        cur = nxt; cA = nA; cB = nB; ++ui;
        if constexpr (ALIGN_EPI) { if (wr == 1) PG8_BAR; }
    }
    PG8_WAIT_V(0);
    if constexpr (!ALIGN_EPI) { if (wr == 0) PG8_BAR; }
    PG8_BAR;
    if constexpr (Epi::AFTER_DRAIN) { E.fused(acc, cur, wr, wc, fr, fq, lds, wid, lane); S.done(cur); }
#undef PG8_SA
#undef PG8_SB
#undef PG8_STAGE
#undef PG8_LDA
#undef PG8_LDB
#undef PG8_MMA
#undef PG8_WAIT_V
#undef PG8_WAIT_L
#undef PG8_BAR
#undef PG8_SCHED
}
}

constexpr int BATCH = 8, SEQ = 4096, DM = 1024, M = BATCH * SEQ, NPROJ = 6424, NPAD = 6656, DFF = 4096;
constexpr float EPS = 1e-6f, LOG2E = 1.4426950408889634f;
constexpr int NWAVES = 8;
constexpr size_t MiB = 1u << 20;
constexpr size_t WS_ROWSS = 0;
constexpr size_t WS_WIN = 2 * MiB, WS_WAB = 15 * MiB  , WS_WO = 18 * MiB, WS_WUP = 20 * MiB, WS_WDN = 28 * MiB;
constexpr size_t WS_WC = 36 * MiB;
constexpr size_t WS_POSB = 36 * MiB + 512 * 1024;
constexpr size_t WS_KCN = 37 * MiB;
constexpr size_t WS_VCT = 38 * MiB;
constexpr size_t WS_VT = 480 * MiB;
constexpr size_t WS_GN = 43 * MiB;
constexpr size_t WS_XN = 48 * MiB;
constexpr size_t WS_Q = 112 * MiB;
constexpr size_t WS_KV = 144 * MiB;
constexpr size_t WS_U = 192 * MiB;
constexpr size_t WS_CB = 256 * MiB;
constexpr size_t WS_ZO = 320 * MiB;
constexpr size_t WS_MIX = 112 * MiB;
constexpr size_t WS_H = 192 * MiB;
constexpr size_t WS_END = 496 * MiB;
constexpr int RING_BYTES = 131072, LDS_BYTES = 147456, MISC_OFF = RING_BYTES + 320;
constexpr size_t WS_BAR = 1 * MiB;

#define LAS __attribute__((address_space(3)))
typedef unsigned short bf16;
typedef unsigned v4u __attribute__((ext_vector_type(4)));
typedef unsigned v2u __attribute__((ext_vector_type(2)));
typedef float f32x4 __attribute__((ext_vector_type(4)));
typedef float f32x16 __attribute__((ext_vector_type(16)));
typedef short bf16x8 __attribute__((ext_vector_type(8)));
typedef short s16x4 __attribute__((ext_vector_type(4)));
typedef float f32x2_t __attribute__((ext_vector_type(2)));
typedef __bf16 bf16x2_t __attribute__((ext_vector_type(2)));
#define LDS_WAIT() asm volatile("s_waitcnt lgkmcnt(0)" ::: "memory")
#define MFMA32(a, b, c) __builtin_amdgcn_mfma_f32_32x32x16_bf16(a, b, c, 0, 0, 0)
__device__ __forceinline__ unsigned pk2(float lo, float hi) { f32x2_t v = {lo, hi}; bf16x2_t b = __builtin_convertvector(v, bf16x2_t); return __builtin_bit_cast(unsigned, b); }
__device__ __forceinline__ float bf2f(bf16 h) { return __uint_as_float((unsigned)h << 16); }
__device__ __forceinline__ float blo(unsigned w) { return __uint_as_float(w << 16); }
__device__ __forceinline__ float bhi(unsigned w) { return __uint_as_float(w & 0xffff0000u); }
__device__ __forceinline__ bf16x8 pack8(float a0, float a1, float a2, float a3, float a4, float a5, float a6, float a7) {
    v4u w; w.x = pk2(a0, a1); w.y = pk2(a2, a3); w.z = pk2(a4, a5); w.w = pk2(a6, a7); return __builtin_bit_cast(bf16x8, w); }
__device__ __forceinline__ int crow(int r, int hi) { return (r & 3) + 8 * (r >> 2) + 4 * hi; }
__device__ __forceinline__ float ex2(float x) { return __builtin_amdgcn_exp2f(x); }

struct Args {
    const float *x, *norm1_g, *w_in, *q_norm_g, *k_norm_g, *cmp_pos_k, *cmp_pos_v, *w_cmp_k, *w_cmp_v, *conv_w, *w_branch_a, *w_branch_b, *w_out, *norm2_g, *w_up, *w_down;
    float* out; unsigned char* ws;
    int never; int pad;
};

#define XB_TMO      128
#define XB_XCNT(j)  (256  + 64 * (j))
#define XB_XSUB(j)  (1280 + 64 * (j))
#define XB_XGEN(j)  (2304 + 64 * (j))
#define XB_TOP      3328
#define XB_TOPGEN   3392
#define XCD_BAR_WORDS 3456
#define XB_SPIN_CAP (1u << 18)

__device__ __forceinline__ unsigned xb_ld(unsigned* p)              { return __hip_atomic_load(p, __ATOMIC_RELAXED, __HIP_MEMORY_SCOPE_AGENT); }
__device__ __forceinline__ unsigned xb_add(unsigned* p, unsigned v) { return __hip_atomic_fetch_add(p, v, __ATOMIC_RELAXED, __HIP_MEMORY_SCOPE_AGENT); }
__device__ __forceinline__ unsigned xb_xcc_id() { return (unsigned)__builtin_amdgcn_s_getreg((3 << 11) | 20) & 0xFu; }
#define XB_SPIN(cond, bar) do { unsigned _sp = 0; while (cond) { __builtin_amdgcn_s_sleep(1); \
    if ((++_sp & 255u) == 0u) { if (xb_ld(&(bar)[XB_TMO])) break; if (_sp > XB_SPIN_CAP) { atomicAdd(&(bar)[XB_TMO], 1u); break; } } } } while (0)

struct XcdBarrier {
    unsigned* bar; unsigned x;
    volatile LAS unsigned* st;
};

__device__ __forceinline__ XcdBarrier xcd_barrier_post(unsigned* bar, volatile LAS unsigned* st) {
    XcdBarrier b; b.bar = bar; b.x = xb_xcc_id(); b.st = st;
    if (threadIdx.x == 0) (void)xb_add(&bar[XB_XCNT(b.x)], 1u);
    return b;
}
__device__ __forceinline__ void xcd_barrier_complete(unsigned* bar, unsigned x, unsigned& nloc, unsigned& nx) {
    const unsigned G = gridDim.x * gridDim.y * gridDim.z;
    unsigned sum, cnt, mine, sp = 0u;
    for (;;) {
        sum = 0u; cnt = 0u; mine = 0u;
#pragma unroll
        for (unsigned j = 0; j < 16; ++j) { const unsigned c = xb_ld(&bar[XB_XCNT(j)]); sum += c; cnt += (c > 0u) ? 1u : 0u; mine = (j == x) ? c : mine; }
        if (sum == G) break;
        __builtin_amdgcn_s_sleep(1);
        if ((++sp & 255u) == 0u) { if (xb_ld(&bar[XB_TMO])) break; if (sp > XB_SPIN_CAP) { atomicAdd(&bar[XB_TMO], 1u); break; } }
    }
    nloc = mine > 0u ? mine : 1u; nx = cnt > 0u ? cnt : 1u;
}

__device__ __forceinline__ void xcd_barrier(const XcdBarrier& b) {
    asm volatile("s_waitcnt vmcnt(0)" ::: "memory");
    __syncthreads();
    if (threadIdx.x == 0) {
        unsigned* bar = b.bar;
        __builtin_amdgcn_s_waitcnt(0);
        unsigned nloc = b.st[0], nx = b.st[1];
        if (nloc == 0u) { xcd_barrier_complete(bar, b.x, nloc, nx); b.st[0] = nloc; b.st[1] = nx; }
        const unsigned old = xb_add(&bar[XB_XSUB(b.x)], 1u);
        const unsigned gen = old / nloc;
        if (old + 1u == (gen + 1u) * nloc) {
            __builtin_amdgcn_fence(__ATOMIC_RELEASE, "agent");
            asm volatile("s_waitcnt vmcnt(0)" ::: "memory");
            const unsigned og = xb_add(&bar[XB_TOP], 1u);
            const unsigned tg = og / nx;
            if (og + 1u == (tg + 1u) * nx) xb_add(&bar[XB_TOPGEN], 1u);
            else XB_SPIN(xb_ld(&bar[XB_TOPGEN]) == tg, bar);
            __builtin_amdgcn_fence(__ATOMIC_ACQUIRE, "agent");
            xb_add(&bar[XB_XGEN(b.x)], 1u);
            asm volatile("s_waitcnt vmcnt(0)" ::: "memory");
        } else {
            XB_SPIN(xb_ld(&bar[XB_XGEN(b.x)]) == gen, bar);
            __builtin_amdgcn_fence(__ATOMIC_ACQUIRE, "agent");
            asm volatile("s_waitcnt vmcnt(0)" ::: "memory");
        }
    }
    __syncthreads();
}

__device__ __forceinline__ int map_win(int ns) {
    if (ns < 1280) return ns;
    if (ns < 1304) return 6400 + (ns - 1280);
    if (ns < 2328) return 3328 + (ns - 1304);
    if (ns < 3352) { const int ch = ns - 2328; return 1280 + (ch >> 7) * 256 + (ch & 127); }
    if (ns < 4376) { const int ch = ns - 3352; return 1280 + (ch >> 7) * 256 + 128 + (ch & 127); }
    if (ns < 5400) { const int ch = ns - 4376; return 4352 + (ch >> 7) * 256 + (ch & 127); }
    { const int ch = ns - 5400; return 4352 + (ch >> 7) * 256 + 128 + (ch & 127); }
}
template <bool MAP> __device__ __forceinline__ void tr_item(const float* W, int K, int N, bf16* WT, int ldk, const float* kscale, LAS float* scr, int item, int lane) {
    const int nblk = (N + 31) / 32, kb = item / nblk, nb = item % nblk, k0 = 64 * kb, n0 = 32 * nb;
    const int nl = n0 + (lane & 31); const bool nok = nl < N;
    float tv[32];
#pragma unroll
    for (int i = 0; i < 32; ++i) { const int kk = 2 * i + (lane >> 5); tv[i] = nok ? __builtin_nontemporal_load(W + (size_t)(k0 + kk) * N + nl) : 0.f; }
#pragma unroll
    for (int i = 0; i < 32; ++i) { const int kk = 2 * i + (lane >> 5); float v = tv[i]; if (kscale) v *= kscale[k0 + kk]; scr[kk * 33 + (lane & 31)] = v; }
    LDS_WAIT(); asm volatile("" ::: "memory");
    const int c = lane & 7;
#pragma unroll
    for (int j = 0; j < 4; ++j) { const int n = (lane >> 3) + 8 * j, ns = n0 + n; const LAS float* s = scr + (8 * c) * 33 + n;
        if (ns < N) { const int dr = MAP ? map_win(ns) : ns;
            v4u o; o.x = pk2(s[0 * 33], s[1 * 33]); o.y = pk2(s[2 * 33], s[3 * 33]); o.z = pk2(s[4 * 33], s[5 * 33]); o.w = pk2(s[6 * 33], s[7 * 33]);
            *(v4u*)(WT + (size_t)dr * ldk + k0 + 8 * c) = o; } }
    LDS_WAIT(); asm volatile("" ::: "memory");
}
__device__ __forceinline__ float wave_sum(float v) {
#pragma unroll
    for (int o = 1; o < 64; o <<= 1) v += __shfl_xor(v, o);
    return v;
}

constexpr int L_KC = 0, L_VCT = 36864, L_K0 = 70144, L_V0 = 88576, L_SC = 105984, L_MB = 122368;
constexpr int KSTR = 72, VSTR = 68, VCSTR = 260;
static_assert(L_MB + 512 <= RING_BYTES, "attention LDS map");

__device__ __forceinline__ void attn_qk(const LAS unsigned char* Kb, const f32x16& cinit, const bf16x8 (&qf)[4], f32x16& p0, f32x16& p1, int r32, int hi) {
    p0 = cinit; p1 = cinit;
    bf16x8 ka[4], kb[4];
#pragma unroll
    for (int kk = 0; kk < 4; ++kk) {
        ka[kk] = *(const LAS bf16x8*)(Kb + (r32 * KSTR + 16 * kk + 8 * hi) * 2);
        kb[kk] = *(const LAS bf16x8*)(Kb + ((32 + r32) * KSTR + 16 * kk + 8 * hi) * 2);
    }
    __builtin_amdgcn_sched_barrier(0);
#pragma unroll
    for (int kk = 0; kk < 4; ++kk) { p0 = MFMA32(ka[kk], qf[kk], p0); p1 = MFMA32(kb[kk], qf[kk], p1); }
}
template <bool WIN>
__device__ __forceinline__ void attn_sp(const LAS unsigned char* Vb, int j, int cur, int tokl, unsigned long long lmask, float slope2,
                                        f32x16& p0, f32x16& p1, f32x16 (&o)[2], float& m, float& l, int r32, int hi) {
    const bool sel = (lmask >> j) & 1ull;
    const float T0 = slope2 * (float)(64 * j), T1 = T0 + 32.f * slope2;
    if (j == cur || (WIN && j == cur - 8)) {
        const int hl = (j == cur) ? tokl - 4 * hi : 99;
        const int ll = (WIN && j != cur) ? tokl - 4 * hi : -1;
#pragma unroll
        for (int r = 0; r < 16; ++r) {
            const int cr = (r & 3) + 8 * (r >> 2);
            p0[r] = (cr > ll && cr <= hl) ? p0[r] : -1e30f; p1[r] = (cr + 32 > ll && cr + 32 <= hl) ? p1[r] : -1e30f;
        }
    }
    float mx0 = fmaxf(fmaxf(p0[0], p0[1]), p0[2]), mx1 = fmaxf(fmaxf(p1[0], p1[1]), p1[2]);
#pragma unroll
    for (int r = 3; r < 15; r += 2) { mx0 = fmaxf(fmaxf(mx0, p0[r]), p0[r + 1]); mx1 = fmaxf(fmaxf(mx1, p1[r]), p1[r + 1]); }
    mx0 = fmaxf(mx0, p0[15]); mx1 = fmaxf(mx1, p1[15]);
    float bm = sel ? fmaxf(mx0 + T0, mx1 + T1) : -1e30f;
    bm = fmaxf(bm, __shfl_xor(bm, 32));
    if (__builtin_amdgcn_ballot_w64(bm > m - 24.0f) == 0ull) return;
    const float mn = fmaxf(m, bm);
    if (__builtin_amdgcn_ballot_w64(mn > m) != 0ull) {
        const float alpha = ex2(m - mn); l *= alpha;
#pragma unroll
        for (int r = 0; r < 16; ++r) { o[0][r] *= alpha; o[1][r] *= alpha; }
    }
    m = mn;
    const bool live = sel && (mn > -1e29f);
    const float c0 = live ? mn - T0 : 1e30f, c1 = live ? mn - T1 : 1e30f;
    p0 = p0 - c0; p1 = p1 - c1;
#pragma unroll
    for (int r = 0; r < 16; ++r) { p0[r] = ex2(p0[r]); p1[r] = ex2(p1[r]); }
    { const f32x16 ps = p0 + p1; l += ((ps[0] + ps[1]) + (ps[2] + ps[3])) + ((ps[4] + ps[5]) + (ps[6] + ps[7])) + ((ps[8] + ps[9]) + (ps[10] + ps[11])) + ((ps[12] + ps[13]) + (ps[14] + ps[15])); }
#pragma unroll
    for (int j4 = 0; j4 < 4; ++j4) {
        bf16x8 pb;
        if (j4 < 2) pb = pack8(p0[8 * (j4 & 1) + 0], p0[8 * (j4 & 1) + 1], p0[8 * (j4 & 1) + 2], p0[8 * (j4 & 1) + 3], p0[8 * (j4 & 1) + 4], p0[8 * (j4 & 1) + 5], p0[8 * (j4 & 1) + 6], p0[8 * (j4 & 1) + 7]);
        else        pb = pack8(p1[8 * (j4 & 1) + 0], p1[8 * (j4 & 1) + 1], p1[8 * (j4 & 1) + 2], p1[8 * (j4 & 1) + 3], p1[8 * (j4 & 1) + 4], p1[8 * (j4 & 1) + 5], p1[8 * (j4 & 1) + 6], p1[8 * (j4 & 1) + 7]);
#pragma unroll
        for (int d0 = 0; d0 < 2; ++d0) {
            const LAS unsigned char* vp = Vb + ((r32 + 32 * d0) * VSTR + 16 * j4 + 4 * hi) * 2;
            const s16x4 lo4 = *(const LAS s16x4*)vp, hi4 = *(const LAS s16x4*)(vp + 16);
            const bf16x8 a = (bf16x8){lo4[0], lo4[1], lo4[2], lo4[3], hi4[0], hi4[1], hi4[2], hi4[3]};
            o[d0] = MFMA32(a, pb, o[d0]);
        }
    }
}

template <bool WIN>
__device__ __forceinline__ void attn_branch(LAS unsigned char* L, const bf16* kvb, const bf16* vtb, unsigned long long umask, unsigned long long lmask,
                                            int cur, int tokl, float slope2, const f32x16& cinit, const bf16x8 (&qf)[4], f32x16 (&o)[2], float& l_out, int tid, int r32, int hi, bool skew, v4u k_first, v4u v_first) {
    o[0] = f32x16{}; o[1] = f32x16{}; float m = -1e30f, l = 0.f;
    const int srow = tid >> 3, sch = tid & 7;
    unsigned long long pend = umask;
#define POP(dst) do { if (pend) { dst = 63 - __builtin_clzll(pend); pend &= ~(1ull << dst); } else dst = -1; } while (0)
#define STAGE_LOAD(kr, vr, jj) do { kr = *(const v4u*)(kvb + (size_t)(64 * (jj) + srow) * 768 + sch * 8); vr = *(const v4u*)(vtb + (size_t)srow * SEQ + 64 * (jj) + sch * 8); } while (0)
#define STAGE_WRITE(kso, vso, kr, vr) do { \
        *(LAS v4u*)(L + L_K0 + (kso) + (srow * KSTR + sch * 8) * 2) = kr; \
        LAS v2u* vt_ = (LAS v2u*)(L + L_V0 + (vso) + (srow * VSTR + sch * 8) * 2); \
        vt_[0] = (v2u){vr.x, vr.y}; vt_[1] = (v2u){vr.z, vr.w}; } while (0)
    int jq0, jq1; POP(jq0); POP(jq1);
    v4u kA = k_first, vA = v_first;
    STAGE_WRITE(0, 0, kA, vA);
    if (jq1 >= 0) STAGE_LOAD(kA, vA, jq1);
    __syncthreads();
    int kso = 0, vso = 0, vsn = 8704, vsp = 0, jprev = -1;
    f32x16 p0, p1;
    for (;;) {
        int jq2 = -1;
        if (jq1 >= 0) { STAGE_WRITE(kso ^ 9216, vsn, kA, vA); POP(jq2); if (jq2 >= 0) STAGE_LOAD(kA, vA, jq2); }
        if (skew) {
            if (jprev >= 0) attn_sp<WIN>(L + L_V0 + vsp, jprev, cur, tokl, lmask, slope2, p0, p1, o, m, l, r32, hi);
            attn_qk(L + L_K0 + kso, cinit, qf, p0, p1, r32, hi);
        } else {
            attn_qk(L + L_K0 + kso, cinit, qf, p0, p1, r32, hi);
            attn_sp<WIN>(L + L_V0 + vso, jq0, cur, tokl, lmask, slope2, p0, p1, o, m, l, r32, hi);
        }
        __syncthreads();
        jprev = jq0; vsp = vso; vso = vsn; vsn = (vsn == 2 * 8704) ? 0 : vsn + 8704; kso ^= 9216;
        if (jq1 < 0) break;
        jq0 = jq1; jq1 = jq2;
    }
    if (skew) attn_sp<WIN>(L + L_V0 + vsp, jprev, cur, tokl, lmask, slope2, p0, p1, o, m, l, r32, hi);
    __syncthreads();
#undef POP
#undef STAGE_LOAD
#undef STAGE_WRITE
    l_out = l + __shfl_xor(l, 32);
}

struct AttnPtrs { const bf16 *Q, *KV, *GN, *KCN, *VCT, *VT; bf16* O; const float* qg; };

__device__ __forceinline__ void attn_unit(const AttnPtrs& A, LAS unsigned char* L, int b, int g, int cur) {
    int tid_ = threadIdx.x; asm volatile("" : "+v"(tid_));
    const int tid = tid_, lane = tid & 63, w = __builtin_amdgcn_readfirstlane(tid >> 6), r32 = lane & 31, hi = lane >> 5;
    const int tokl = 8 * w + (r32 >> 2), head = r32 & 3, hq = g * 4 + head, t = 64 * cur + tokl;
    const size_t mrow = (size_t)b * SEQ + t;
    const float slope2 = ex2(-(float)(hq + 1)) * LOG2E;
    bf16x8 qf[4];
    {
        const bf16* qp = A.Q + mrow * 512 + hq * 64 + 8 * hi;
        v4u qw[4]; float ss = 0.f;
#pragma unroll
        for (int kk = 0; kk < 4; ++kk) qw[kk] = *(const v4u*)(qp + 16 * kk);
#pragma unroll
        for (int kk = 0; kk < 4; ++kk) { const v4u w_ = qw[kk];
            ss += (blo(w_.x) * blo(w_.x) + bhi(w_.x) * bhi(w_.x)) + (blo(w_.y) * blo(w_.y) + bhi(w_.y) * bhi(w_.y)) + (blo(w_.z) * blo(w_.z) + bhi(w_.z) * bhi(w_.z)) + (blo(w_.w) * blo(w_.w) + bhi(w_.w) * bhi(w_.w)); }
        ss += __shfl_xor(ss, 32);
        const float rq = __builtin_amdgcn_rsqf(ss * (1.f / 64.f) + EPS) * (0.125f * LOG2E);
#pragma unroll
        for (int kk = 0; kk < 4; ++kk) { const v4u w_ = qw[kk]; const f32x4 ga = *(const f32x4*)(A.qg + 16 * kk + 8 * hi), gb = *(const f32x4*)(A.qg + 16 * kk + 8 * hi + 4);
            qf[kk] = pack8(blo(w_.x) * rq * ga[0], bhi(w_.x) * rq * ga[1], blo(w_.y) * rq * ga[2], bhi(w_.y) * rq * ga[3], blo(w_.z) * rq * gb[0], bhi(w_.z) * rq * gb[1], blo(w_.w) * rq * gb[2], bhi(w_.w) * rq * gb[3]); }
    }
    const float g0 = bf2f(A.GN[mrow * 32 + hq]), g1 = bf2f(A.GN[mrow * 32 + 8 + hq]), g2 = bf2f(A.GN[mrow * 32 + 16 + hq]);
    const int ncv = (4 * cur + 3 < 255) ? 4 * cur + 3 : 255, nblk = (ncv + 31) >> 5, nrow = nblk * 32;
    v4u kr[4], vr[4];
    {
        const bf16* kc = A.KCN + (size_t)(b * 2 + g) * 256 * 64; const bf16* vc = A.VCT + (size_t)(b * 2 + g) * 64 * 256;
#pragma unroll
        for (int i = 0; i < 4; ++i) {
            const int ck = i * 512 + tid, row = ck >> 3;
            kr[i] = (row < nrow) ? *(const v4u*)(kc + (size_t)ck * 8) : (v4u){0u, 0u, 0u, 0u};
            const int d = ck >> 5, cc = (ck & 31) * 8;
            vr[i] = (cc < nrow) ? *(const v4u*)(vc + (size_t)d * 256 + cc) : (v4u){0u, 0u, 0u, 0u};
        }
    }
    __syncthreads();
    {
#pragma unroll
        for (int i = 0; i < 4; ++i) {
            const int ck = i * 512 + tid, row = ck >> 3, d = ck >> 5, cc = (ck & 31) * 8;
            if (row < nrow) *(LAS v4u*)(L + L_KC + (row * KSTR + (ck & 7) * 8) * 2) = kr[i];
            if (cc < nrow) { LAS v2u* vp = (LAS v2u*)(L + L_VCT + (d * VCSTR + cc) * 2); vp[0] = (v2u){vr[i].x, vr[i].y}; vp[1] = (v2u){vr[i].z, vr[i].w}; }
        }
    }
    __syncthreads();
    f32x16 cinit;
#pragma unroll
    for (int r = 0; r < 16; ++r) cinit[r] = slope2 * (float)((r & 3) + 8 * (r >> 2) + 4 * hi);
    const int clim_l = ((t - 31) >> 4) - 4 * hi;
    const bool need_imp = cur >= 16;
    LAS f32x4* park = (LAS f32x4*)(L + w * 8192) + lane;
    float imp[33];
#pragma unroll
    for (int i = 0; i < 33; ++i) imp[i] = 0.f;
    {
        f32x16 oc[2]; oc[0] = f32x16{}; oc[1] = f32x16{};
        float m1 = -1e30f, l1 = 0.f;
#pragma unroll
        for (int bi = 0; bi < 8; ++bi) {
            const int blk = 7 - bi;
            if (blk < nblk) {
                f32x16 p = f32x16{};
                { bf16x8 kc4[4];
#pragma unroll
                  for (int kk = 0; kk < 4; ++kk) kc4[kk] = *(const LAS bf16x8*)(L + L_KC + ((32 * blk + r32) * KSTR + 16 * kk + 8 * hi) * 2);
                  __builtin_amdgcn_sched_barrier(0);
#pragma unroll
                  for (int kk = 0; kk < 4; ++kk) p = MFMA32(kc4[kk], qf[kk], p); }
                if (32 * blk + 31 > 4 * cur - 2) {
#pragma unroll
                    for (int r = 0; r < 16; ++r) p[r] = (32 * blk + (r & 3) + 8 * (r >> 2) <= clim_l) ? fmaf(cinit[r], 16.f, p[r]) : -1e30f;
                } else {
#pragma unroll
                    for (int r = 0; r < 16; ++r) p[r] = fmaf(cinit[r], 16.f, p[r]);
                }
                const float Tb = slope2 * 512.f * (float)blk;
                float mx = fmaxf(fmaxf(p[0], p[1]), p[2]);
#pragma unroll
                for (int r = 3; r < 15; r += 2) mx = fmaxf(fmaxf(mx, p[r]), p[r + 1]);
                mx = fmaxf(mx, p[15]);
                float bm = mx + Tb; bm = fmaxf(bm, __shfl_xor(bm, 32));
                const float mn = fmaxf(m1, bm);
                if (__builtin_amdgcn_ballot_w64(mn > m1) != 0ull) {
                    const float alpha = ex2(m1 - mn); l1 *= alpha;
#pragma unroll
                    for (int r = 0; r < 16; ++r) { oc[0][r] *= alpha; oc[1][r] *= alpha; }
                    if (need_imp) {
#pragma unroll
                        for (int i = 0; i < 33; ++i) imp[i] *= alpha;
                    }
                }
                m1 = mn;
                const float c2 = (mn > -1e29f) ? mn - Tb : 1e30f;
                float rs = 0.f;
#pragma unroll
                for (int r = 0; r < 16; ++r) { p[r] = ex2(p[r] - c2); rs += p[r]; }
                l1 += rs;
                if (need_imp) {
#pragma unroll
                    for (int a = 0; a < 4; ++a) {
                        const float sp = 0.5f * p[4 * a + 3], v = p[4 * a] + p[4 * a + 1] + p[4 * a + 2] + sp, rc = __shfl_xor(sp, 32);
                        imp[4 * blk + a] += v + (hi ? rc : 0.f); imp[4 * blk + a + 1] += (hi ? 0.f : rc);
                    }
                }
#pragma unroll
                for (int j2 = 0; j2 < 2; ++j2) {
                    const bf16x8 pb = pack8(p[8 * j2 + 0], p[8 * j2 + 1], p[8 * j2 + 2], p[8 * j2 + 3], p[8 * j2 + 4], p[8 * j2 + 5], p[8 * j2 + 6], p[8 * j2 + 7]);
#pragma unroll
                    for (int d0 = 0; d0 < 2; ++d0) {
                        const LAS unsigned char* vp = L + L_VCT + ((r32 + 32 * d0) * VCSTR + 32 * blk + 16 * j2 + 4 * hi) * 2;
                        const s16x4 lo4 = *(const LAS s16x4*)vp, hi4 = *(const LAS s16x4*)(vp + 16);
                        const bf16x8 a = (bf16x8){lo4[0], lo4[1], lo4[2], lo4[3], hi4[0], hi4[1], hi4[2], hi4[3]};
                        oc[d0] = MFMA32(a, pb, oc[d0]);
                    }
                }
            }
        }
        const float Lt = l1 + __shfl_xor(l1, 32), inv = 1.0f / fmaxf(Lt, 1e-30f), gi = g0 * inv;
        __syncthreads();
#pragma unroll
        for (int k = 0; k < 4; ++k) {
            park[64 * k] = (f32x4){gi * oc[0][4 * k], gi * oc[0][4 * k + 1], gi * oc[0][4 * k + 2], gi * oc[0][4 * k + 3]};
            park[64 * (4 + k)] = (f32x4){gi * oc[1][4 * k], gi * oc[1][4 * k + 1], gi * oc[1][4 * k + 2], gi * oc[1][4 * k + 3]};
        }
        if (need_imp) {
#pragma unroll
            for (int i = 0; i < 32; ++i) imp[i] *= inv;
        }
    }
    const bf16* kvb = A.KV + (size_t)b * SEQ * 768 + g * 64;
    const bf16* vts = A.VT + (size_t)((b * 2 + 0) * 2 + g) * 64 * SEQ; const bf16* vtw = A.VT + (size_t)((b * 2 + 1) * 2 + g) * 64 * SEQ;
    const v4u ks0 = *(const v4u*)(kvb + 256 + (size_t)(64 * cur + (tid >> 3)) * 768 + (tid & 7) * 8), vs0 = *(const v4u*)(vts + (size_t)(tid >> 3) * SEQ + 64 * cur + (tid & 7) * 8);
    const unsigned long long causal = (cur >= 63) ? ~0ull : ((2ull << cur) - 1ull);
    unsigned long long lmask = causal, umask = causal;
    if (cur >= 16) {
#pragma unroll
        for (int i = 0; i < 32; ++i) { imp[i] += __shfl_xor(imp[i], 1); imp[i] += __shfl_xor(imp[i], 2); }
        if (head == 0) {
            LAS unsigned* sc = (LAS unsigned*)(L + L_SC) + tokl * 64 + hi;
#pragma unroll
            for (int i = 0; i < 32; ++i) { const int jj = 2 * i + hi; const bool forced = (jj == 0) || (jj == cur) || (jj == cur - 1);
                const unsigned kb = forced ? __float_as_uint(1e4f) : ((jj <= cur) ? __float_as_uint(imp[i]) : 0u); sc[2 * i] = (kb & ~63u) | (unsigned)(63 - jj); }
        }
        __syncthreads();
        {
            const int tok = tid >> 3, part = tid & 7; const LAS unsigned* row = (const LAS unsigned*)(L + L_SC) + tok * 64;
            unsigned mine[8]; int rank[8];
#pragma unroll
            for (int e = 0; e < 8; ++e) { mine[e] = row[part * 8 + e]; rank[e] = 0; }
            for (int jj = 0; jj <= cur; jj += 4) {
                const v4u k4 = *(const LAS v4u*)(row + jj);
#pragma unroll
                for (int q = 0; q < 4; ++q) {
#pragma unroll
                    for (int e = 0; e < 8; ++e) rank[e] += (k4[q] > mine[e]) ? 1 : 0;
                }
            }
            unsigned bits = 0u;
#pragma unroll
            for (int e = 0; e < 8; ++e) bits |= (rank[e] < 16 ? 1u : 0u) << e;
            ((LAS unsigned char*)(L + L_MB))[tok * 8 + part] = (unsigned char)bits;
        }
        __syncthreads();
        const v2u mw = *(const LAS v2u*)(L + L_MB + tokl * 8);
        lmask = (((unsigned long long)mw.y << 32) | mw.x) & causal;
        v2u uw = *(const LAS v2u*)(L + L_MB + lane * 8);
#pragma unroll
        for (int o_ = 1; o_ < 64; o_ <<= 1) { uw.x |= (unsigned)__shfl_xor((int)uw.x, o_); uw.y |= (unsigned)__shfl_xor((int)uw.y, o_); }
        umask = ((((unsigned long long)(unsigned)__builtin_amdgcn_readfirstlane((int)uw.y)) << 32) | (unsigned)__builtin_amdgcn_readfirstlane((int)uw.x)) & causal;
    }
    v4u kw0, vw0;
    {
        f32x16 o[2]; float lt;
        attn_branch<false>(L, kvb + 256, vts, umask, lmask, cur, tokl, slope2, cinit, qf, o, lt, tid, r32, hi, false, ks0, vs0);
        kw0 = *(const v4u*)(kvb + 512 + (size_t)(64 * cur + (tid >> 3)) * 768 + (tid & 7) * 8); vw0 = *(const v4u*)(vtw + (size_t)(tid >> 3) * SEQ + 64 * cur + (tid & 7) * 8);
        const float sc = g1 / lt;
#pragma unroll
        for (int k = 0; k < 4; ++k) {
            park[64 * k] += (f32x4){sc * o[0][4 * k], sc * o[0][4 * k + 1], sc * o[0][4 * k + 2], sc * o[0][4 * k + 3]};
            park[64 * (4 + k)] += (f32x4){sc * o[1][4 * k], sc * o[1][4 * k + 1], sc * o[1][4 * k + 2], sc * o[1][4 * k + 3]};
        }
    }
    {
        const int jlo = (cur >= 8) ? cur - 8 : 0;
        const unsigned long long wmask = causal & ~((1ull << jlo) - 1ull);
        f32x16 o[2]; float lt;
                attn_branch<true>(L, kvb + 512, vtw, wmask, ~0ull, cur, tokl, slope2, cinit, qf, o, lt, tid, r32, hi, false, kw0, vw0);
        const float sc = g2 / lt;
        bf16* op = A.O + mrow * 1536 + hq * 64 + 4 * hi;
#pragma unroll
        for (int d0 = 0; d0 < 2; ++d0)
#pragma unroll
            for (int a = 0; a < 4; ++a) {
                const f32x4 pv = park[64 * (4 * d0 + a)];
                v2u wv; wv.x = pk2(pv[0] + sc * o[d0][4 * a], pv[1] + sc * o[d0][4 * a + 1]); wv.y = pk2(pv[2] + sc * o[d0][4 * a + 2], pv[3] + sc * o[d0][4 * a + 3]);
                *(v2u*)(op + 32 * d0 + 8 * a) = wv;
            }
    }
}

__global__ void __launch_bounds__(NWAVES * 64, 2) nsa_block_fwd(Args a) {
    extern __shared__ __attribute__((aligned(16))) unsigned char lds_raw[];
    cg::grid_group grid = cg::this_grid();
    LAS unsigned char* lds = (LAS unsigned char*)lds_raw;
    const int tid = threadIdx.x, lane = tid & 63, wave = __builtin_amdgcn_readfirstlane(tid >> 6);
    const int G = gridDim.x, bx = blockIdx.x, vcu = (G % 8 == 0) ? (bx % 8) * (G / 8) + bx / 8 : bx;
    unsigned char* ws = a.ws;
    float* rowss = (float*)(ws + WS_ROWSS);
    bf16 *WIN_t = (bf16*)(ws + WS_WIN), *WAB_t = (bf16*)(ws + WS_WAB), *WO_t = (bf16*)(ws + WS_WO), *WUP_t = (bf16*)(ws + WS_WUP), *WDN_t = (bf16*)(ws + WS_WDN);
    bf16 *WC_t = (bf16*)(ws + WS_WC);
    bf16 *KCN = (bf16*)(ws + WS_KCN), *VCT = (bf16*)(ws + WS_VCT), *VT = (bf16*)(ws + WS_VT);
    bf16 *GN = (bf16*)(ws + WS_GN), *XN = (bf16*)(ws + WS_XN), *QB = (bf16*)(ws + WS_Q), *KVB = (bf16*)(ws + WS_KV), *UB = (bf16*)(ws + WS_U), *CB = (bf16*)(ws + WS_CB);
    bf16 *GA = (bf16*)a.out, *GB = (bf16*)a.out + (size_t)M * 1024, *ZO = (bf16*)(ws + WS_ZO), *MIX = (bf16*)(ws + WS_MIX), *HB = (bf16*)(ws + WS_H);
    const int gw = vcu * NWAVES + wave, NGW = G * NWAVES;
    unsigned* barw = (unsigned*)(ws + WS_BAR);
    for (int u = tid; u < (LDS_BYTES - RING_BYTES) / 4; u += NWAVES * 64) ((LAS unsigned*)(lds + RING_BYTES))[u] = 0u;
    __syncthreads();
    const XcdBarrier xbar = xcd_barrier_post(barw, (volatile LAS unsigned*)(lds + MISC_OFF) + 8);
    if (a.never) grid.sync();

    {
        LAS float* scr = (LAS float*)(lds + wave * 16384);
        constexpr int I_IN = 16 * 201, I_A = 8 * 32, I_B = 16 * 32, I_O = 16 * 32, I_UP = 16 * 128, I_DN = 64 * 32, I_C = 32 * 2;
        constexpr int I_PAD = NPAD - NPROJ, I_Z = M / 4096;
        constexpr int NITEMS = I_IN + I_A + I_B + I_O + I_UP + I_DN + 2 * I_C + I_PAD + I_Z;
        for (int it = gw; it < NITEMS; it += NGW) {
            int r = it;
            if (r < I_IN) { tr_item<true>(a.w_in, 1024, NPROJ, WIN_t, 1024, nullptr, scr, r, lane); continue; } r -= I_IN;
            if (r < I_A) { tr_item<false>(a.w_branch_a, 512, 1024, WAB_t, 1536, nullptr, scr, r, lane); continue; } r -= I_A;
            if (r < I_B) { tr_item<false>(a.w_branch_b, 1024, 1024, WAB_t + 512, 1536, nullptr, scr, r, lane); continue; } r -= I_B;
            if (r < I_O) { tr_item<false>(a.w_out, 1024, 1024, WO_t, 1024, nullptr, scr, r, lane); continue; } r -= I_O;
            if (r < I_UP) { tr_item<false>(a.w_up, 1024, 4096, WUP_t, 1024, a.norm2_g, scr, r, lane); continue; } r -= I_UP;
            if (r < I_DN) { tr_item<false>(a.w_down, 4096, 1024, WDN_t, 4096, nullptr, scr, r, lane); continue; } r -= I_DN;
            if (r < I_C) { tr_item<false>(a.w_cmp_k, 2048, 64, WC_t, 2048, nullptr, scr, r, lane); continue; } r -= I_C;
            if (r < I_C) { tr_item<false>(a.w_cmp_v, 2048, 64, WC_t + 64 * 2048, 2048, nullptr, scr, r, lane); continue; } r -= I_C;
            if (r < I_PAD) { v4u z = (v4u){0u, 0u, 0u, 0u}; v4u* p = (v4u*)(WIN_t + (size_t)(NPROJ + r) * 1024) + lane * 2; p[0] = z; p[1] = z; continue; } r -= I_PAD;
            { f32x4 z = (f32x4){0.f, 0.f, 0.f, 0.f}; f32x4* p = (f32x4*)(rowss + (size_t)r * 4096) + lane;
#pragma unroll
              for (int i = 0; i < 16; ++i) p[64 * i] = z; }
        }
        for (int m = gw; m < M; m += 4 * NGW) {
            const f32x4* gr = (const f32x4*)a.norm1_g + lane;
            f32x4 v[4][4];
#pragma unroll
            for (int q = 0; q < 4; ++q) { const int mm = (m + q * NGW < M) ? m + q * NGW : m; const f32x4* xr = (const f32x4*)(a.x + (size_t)mm * DM) + lane;
#pragma unroll
                for (int j = 0; j < 4; ++j) v[q][j] = __builtin_nontemporal_load(xr + 64 * j); }
#pragma unroll
            for (int q = 0; q < 4; ++q) {
                float sq = 0.f;
#pragma unroll
                for (int j = 0; j < 4; ++j) sq += (v[q][j].x * v[q][j].x + v[q][j].y * v[q][j].y) + (v[q][j].z * v[q][j].z + v[q][j].w * v[q][j].w);
                const float rstd = __builtin_amdgcn_rsqf(wave_sum(sq) * (1.f / DM) + EPS);
                if (m + q * NGW < M) {
                    v2u* o8 = (v2u*)(XN + (size_t)(m + q * NGW) * DM) + lane;
#pragma unroll
                    for (int j = 0; j < 4; ++j) { const f32x4 gg = gr[64 * j]; v2u wv; wv.x = pk2(v[q][j].x * rstd * gg.x, v[q][j].y * rstd * gg.y); wv.y = pk2(v[q][j].z * rstd * gg.z, v[q][j].w * rstd * gg.w); o8[64 * j] = wv; }
                }
            }
        }
    }
    xcd_barrier(xbar);

    {
        pg8::Gemm g{XN, WIN_t, M, NPAD, 1024}; pg8::StaticOrder S; S.init(M, NPAD, G, bx);
        pg8::EpiProj E{QB, KVB, UB, CB, GA, GB, GN, VT};
        pg8::gemm_phase<pg8::EpiProj, pg8::StaticOrder, true, true>(lds, g, S, E);
    }
    xcd_barrier(xbar);

    {
        const int r32 = lane & 31, hi = lane >> 5;
        const int e0 = (lane & 7) * 8;
        float kgv[8];
#pragma unroll
        for (int e = 0; e < 8; ++e) kgv[e] = a.k_norm_g[64 * (1 + ((lane >> 4) & 1)) + e0 + e];
        for (int rb = gw; rb < M / 16; rb += NGW) {
            const int m0 = rb * 16, tt0 = m0 & (SEQ - 1), bb = m0 / SEQ;
            const int kcol = (((lane >> 4) & 1) ? 512 : 256) + (lane & 15) * 8;
#pragma unroll 1
            for (int k4 = 0; k4 < 16; k4 += 4) {
                v4u kw[4];
#pragma unroll
                for (int i = 0; i < 4; ++i) { kw[i] = (v4u){0u, 0u, 0u, 0u}; if (lane < 32) kw[i] = *(const v4u*)(KVB + (size_t)(m0 + k4 + i) * 768 + kcol); }
#pragma unroll
                for (int i = 0; i < 4; ++i) {
                    const v4u w = kw[i];
                    float f[8] = {blo(w.x), bhi(w.x), blo(w.y), bhi(w.y), blo(w.z), bhi(w.z), blo(w.w), bhi(w.w)};
                    float ss = 0.f;
#pragma unroll
                    for (int e = 0; e < 8; ++e) ss += f[e] * f[e];
                    ss += __shfl_xor(ss, 1); ss += __shfl_xor(ss, 2); ss += __shfl_xor(ss, 4);
                    const float rstd = __builtin_amdgcn_rsqf(ss * (1.f / 64.f) + EPS);
                    v4u o; o.x = pk2(f[0] * rstd * kgv[0], f[1] * rstd * kgv[1]); o.y = pk2(f[2] * rstd * kgv[2], f[3] * rstd * kgv[3]); o.z = pk2(f[4] * rstd * kgv[4], f[5] * rstd * kgv[5]); o.w = pk2(f[6] * rstd * kgv[6], f[7] * rstd * kgv[7]);
                    if (lane < 32) *(v4u*)(KVB + (size_t)(m0 + k4 + i) * 768 + kcol) = o;
                }
            }
#pragma unroll 1
            for (int h = 0; h < 2; ++h) {
                const int ch = (h * 64 + lane) * 8;
                const f32x4 wa0 = *(const f32x4*)(a.conv_w + ch), wa1 = *(const f32x4*)(a.conv_w + ch + 4);
                const f32x4 wb0 = *(const f32x4*)(a.conv_w + 1024 + ch), wb1 = *(const f32x4*)(a.conv_w + 1024 + ch + 4);
                const f32x4 wc0 = *(const f32x4*)(a.conv_w + 2048 + ch), wc1 = *(const f32x4*)(a.conv_w + 2048 + ch + 4);
                v4u u1 = (v4u){0u, 0u, 0u, 0u}, u2 = (v4u){0u, 0u, 0u, 0u};
                if (tt0 != 0) { u1 = *(const v4u*)(UB + (size_t)(m0 - 1) * 1024 + ch); u2 = *(const v4u*)(UB + (size_t)(m0 - 2) * 1024 + ch); }
#pragma unroll 1
                for (int k4 = 0; k4 < 16; k4 += 4) {
                    v4u uu[4], cbv[4];
#pragma unroll
                    for (int i = 0; i < 4; ++i) { uu[i] = *(const v4u*)(UB + (size_t)(m0 + k4 + i) * 1024 + ch); cbv[i] = *(const v4u*)(CB + (size_t)(m0 + k4 + i) * 1024 + ch); }
#pragma unroll
                    for (int i = 0; i < 4; ++i) {
                        const v4u u0 = uu[i], cb = cbv[i]; v4u o;
                        o.x = pk2(blo(cb.x) * (wa0[0] * blo(u2.x) + wb0[0] * blo(u1.x) + wc0[0] * blo(u0.x)), bhi(cb.x) * (wa0[1] * bhi(u2.x) + wb0[1] * bhi(u1.x) + wc0[1] * bhi(u0.x)));
                        o.y = pk2(blo(cb.y) * (wa0[2] * blo(u2.y) + wb0[2] * blo(u1.y) + wc0[2] * blo(u0.y)), bhi(cb.y) * (wa0[3] * bhi(u2.y) + wb0[3] * bhi(u1.y) + wc0[3] * bhi(u0.y)));
                        o.z = pk2(blo(cb.z) * (wa1[0] * blo(u2.z) + wb1[0] * blo(u1.z) + wc1[0] * blo(u0.z)), bhi(cb.z) * (wa1[1] * bhi(u2.z) + wb1[1] * bhi(u1.z) + wc1[1] * bhi(u0.z)));
                        o.w = pk2(blo(cb.w) * (wa1[2] * blo(u2.w) + wb1[2] * blo(u1.w) + wc1[2] * blo(u0.w)), bhi(cb.w) * (wa1[3] * bhi(u2.w) + wb1[3] * bhi(u1.w) + wc1[3] * bhi(u0.w)));
                        *(v4u*)(ZO + (size_t)(m0 + k4 + i) * 1536 + 512 + ch) = o;
                        u2 = u1; u1 = u0;
                    }
                }
            }
        }
        for (int task = vcu; task < 256; task += G) {
            const int mat = task >> 7, rt = task & 127;
            const int R = rt * 32 + r32, bb = R >> 9, cc = (R >> 1) & 255, gg = R & 1;
            const bf16* abase = KVB + (size_t)(bb * SEQ + 16 * cc) * 768 + mat * 128 + gg * 64 + 8 * hi;
            const float* pos = (mat ? a.cmp_pos_v : a.cmp_pos_k) + 8 * hi;
            const bf16* wb = WC_t + (size_t)mat * (64 * 2048) + (size_t)r32 * 2048 + 8 * hi;
            f32x16 acc0 = f32x16{}, acc1 = f32x16{};
#pragma unroll
            for (int i = 0; i < 16; ++i) {
                const int kk = wave * 16 + i, l = kk >> 2, dd = (kk & 3) * 16;
                const v4u av = *(const v4u*)(abase + (size_t)l * 768 + dd);
                const f32x4 q0 = *(const f32x4*)(pos + l * 64 + dd), q1 = *(const f32x4*)(pos + l * 64 + dd + 4);
                const bf16x8 ap = pack8(blo(av.x) + q0[0], bhi(av.x) + q0[1], blo(av.y) + q0[2], bhi(av.y) + q0[3], blo(av.z) + q1[0], bhi(av.z) + q1[1], blo(av.w) + q1[2], bhi(av.w) + q1[3]);
                const bf16x8 b0 = *(const bf16x8*)(wb + 16 * kk), b1 = *(const bf16x8*)(wb + 32 * 2048 + 16 * kk);
                acc0 = MFMA32(ap, b0, acc0); acc1 = MFMA32(ap, b1, acc1);
            }
            LAS float* red = (LAS float*)lds + wave * 2048;
#pragma unroll
            for (int r = 0; r < 16; ++r) { red[crow(r, hi) * 64 + r32] = acc0[r]; red[crow(r, hi) * 64 + 32 + r32] = acc1[r]; }
            __syncthreads();
            {
                const int row = tid >> 4, c4 = (tid & 15) * 4;
                f32x4 sm = (f32x4){0.f, 0.f, 0.f, 0.f};
#pragma unroll
                for (int w8 = 0; w8 < 8; ++w8) sm += *(const LAS f32x4*)((LAS float*)lds + w8 * 2048 + row * 64 + c4);
                const int R2 = rt * 32 + row, b2 = R2 >> 9, c2 = (R2 >> 1) & 255, g2 = R2 & 1;
                if (c2 == 255) sm = (f32x4){0.f, 0.f, 0.f, 0.f};
                if (mat == 0) {
                    float ss = (sm[0] * sm[0] + sm[1] * sm[1]) + (sm[2] * sm[2] + sm[3] * sm[3]);
                    ss += __shfl_xor(ss, 1); ss += __shfl_xor(ss, 2); ss += __shfl_xor(ss, 4); ss += __shfl_xor(ss, 8);
                    const float rstd = __builtin_amdgcn_rsqf(ss * (1.f / 64.f) + EPS);
                    const f32x4 kg = *(const f32x4*)(a.k_norm_g + c4);
                    v2u o; o.x = pk2(sm[0] * rstd * kg[0], sm[1] * rstd * kg[1]); o.y = pk2(sm[2] * rstd * kg[2], sm[3] * rstd * kg[3]);
                    *(v2u*)(KCN + ((size_t)((b2 * 2 + g2) * 256 + c2)) * 64 + c4) = o;
                } else {
                    bf16* vo = VCT + ((size_t)(b2 * 2 + g2) * 64 + c4) * 256 + c2;
                    const unsigned w0 = pk2(sm[0], sm[1]), w1 = pk2(sm[2], sm[3]);
                    vo[0] = (bf16)(w0 & 0xffffu); vo[256] = (bf16)(w0 >> 16); vo[512] = (bf16)(w1 & 0xffffu); vo[768] = (bf16)(w1 >> 16);
                }
            }
            __syncthreads();
        }
    }
    xcd_barrier(xbar);

    {
        const AttnPtrs A{QB, KVB, GN, KCN, VCT, VT, ZO, a.q_norm_g};
        volatile LAS int* qslot = (volatile LAS int*)(lds + MISC_OFF) + 16;
        unsigned* queue = barw + XCD_BAR_WORDS + 64;
        int idx = bx;
        while (idx < 1024) {
            int nxt = 0;
            if (tid == 0) nxt = (int)atomicAdd(queue, 1u) + G;
            int b_, g_, cur_;
            if (idx < 368) { g_ = 1; cur_ = 63 - (idx >> 3); b_ = idx & 7; }
            else if (idx < 752) { const int r2 = idx - 368; if (r2 < 376) { g_ = 0; cur_ = 63 - (r2 >> 3); b_ = r2 & 7; } else { g_ = 1; cur_ = 17; b_ = r2 - 376; } }
            else { const int r3 = idx - 752; cur_ = 16 - (r3 >> 4); g_ = (r3 >> 3) & 1; b_ = r3 & 7; }
            attn_unit(A, lds, b_, g_, cur_);
            if (tid == 0) qslot[0] = nxt;
            __syncthreads();
            idx = qslot[0];
            __syncthreads();
        }
    }
    xcd_barrier(xbar);

    {
        pg8::Gemm g{ZO, WAB_t, M, 1024, 1536}; pg8::StaticOrder S; S.init(M, 1024, G, bx);
        pg8::EpiMix E{GA, GB, MIX, 1024};
        pg8::gemm_phase<pg8::EpiMix, pg8::StaticOrder, true, true>(lds, g, S, E);
    }
    xcd_barrier(xbar);
    {
        pg8::Gemm g{MIX, WO_t, M, 1024, 1024}; pg8::StaticOrder S; S.init(M, 1024, G, bx);
        pg8::EpiX1 E{a.x, XN, rowss};
        pg8::gemm_phase<pg8::EpiX1, pg8::StaticOrder, true, true>(lds, g, S, E);
    }
    xcd_barrier(xbar);
    {
        pg8::Gemm g{XN, WUP_t, M, DFF, 1024}; pg8::StaticOrder S; S.init(M, DFF, G, bx);
        pg8::EpiUp E{rowss, HB, DFF, {}};
        pg8::gemm_phase<pg8::EpiUp, pg8::StaticOrder, true, true>(lds, g, S, E);
    }
    xcd_barrier(xbar);
    {
        pg8::Gemm g{HB, WDN_t, M, 1024, DFF}; pg8::StaticOrder S; S.init(M, 1024, G, bx);
        pg8::EpiDown E{XN, a.out};
        pg8::gemm_phase<pg8::EpiDown, pg8::StaticOrder, true, true>(lds, g, S, E);
    }
}

extern "C" void kernel_launch(void* const* d_in, const int* in_sizes, int n_in, void* d_out, int out_size, void* d_ws, size_t ws_size, hipStream_t stream) {
    static int grid = 0;
    if (grid == 0) {
        if (n_in != 16 || out_size != M * DM || ws_size < WS_END) { fprintf(stderr, "kernel_launch: unexpected shapes (n_in %d, out %d, ws %zu)\n", n_in, out_size, ws_size); grid = -1; return; }
        int dev = 0, cus = 0, per_cu = 0;
        (void)hipGetDevice(&dev); (void)hipDeviceGetAttribute(&cus, hipDeviceAttributeMultiprocessorCount, dev);
        if (hipFuncSetAttribute((const void*)nsa_block_fwd, hipFuncAttributeMaxDynamicSharedMemorySize, LDS_BYTES) != hipSuccess) { fprintf(stderr, "kernel_launch: hipFuncSetAttribute failed\n"); grid = -1; return; }
        if (hipOccupancyMaxActiveBlocksPerMultiprocessor(&per_cu, (const void*)nsa_block_fwd, NWAVES * 64, LDS_BYTES) != hipSuccess || per_cu < 1) { fprintf(stderr, "kernel_launch: occupancy query says %d\n", per_cu); per_cu = 1; }
        (void)hipGetLastError();
        grid = cus * 1;
    }
    if (grid < 0) return;
    if (hipMemsetAsync((char*)d_ws + WS_BAR, 0, (XCD_BAR_WORDS + 128) * sizeof(unsigned), stream) != hipSuccess) { fprintf(stderr, "kernel_launch: hipMemsetAsync failed\n"); return; }
    Args a{};
    a.x = (const float*)d_in[0]; a.norm1_g = (const float*)d_in[1]; a.w_in = (const float*)d_in[2]; a.q_norm_g = (const float*)d_in[3]; a.k_norm_g = (const float*)d_in[4];
    a.cmp_pos_k = (const float*)d_in[5]; a.cmp_pos_v = (const float*)d_in[6]; a.w_cmp_k = (const float*)d_in[7]; a.w_cmp_v = (const float*)d_in[8]; a.conv_w = (const float*)d_in[9];
    a.w_branch_a = (const float*)d_in[10]; a.w_branch_b = (const float*)d_in[11]; a.w_out = (const float*)d_in[12]; a.norm2_g = (const float*)d_in[13]; a.w_up = (const float*)d_in[14]; a.w_down = (const float*)d_in[15];
    a.out = (float*)d_out; a.ws = (unsigned char*)d_ws;
    void* args[] = {&a};
    hipError_t e = hipLaunchCooperativeKernel((const void*)nsa_block_fwd, dim3(grid), dim3(NWAVES * 64), args, LDS_BYTES, stream);
    if (e != hipSuccess) fprintf(stderr, "kernel_launch: cooperative launch failed: %s (grid %d)\n", hipGetErrorString(e), grid);
}
```

```cpp
#include <hip/hip_runtime.h>
#include <hip/hip_cooperative_groups.h>
#include <cstdio>
#include <cstdint>
namespace cg = cooperative_groups;
namespace pg8 {
#define PG8_LAS __attribute__((address_space(3)))
typedef unsigned short bf16_t;
typedef short bf16x8 __attribute__((ext_vector_type(8)));
typedef float f32x4 __attribute__((ext_vector_type(4)));
typedef unsigned u32x4 __attribute__((ext_vector_type(4)));
constexpr int BM = 256, BK = 64, HALF = 128, HTB = HALF * BK * 2  , STAGE_BYTES = 8 * HTB, NXCD = 8, WGM = 8;

__host__ __device__ __forceinline__ int lds_byte(int r, int c) { const int st = (r >> 4) * 2 + (c >> 5), rr = r & 15, cc = c & 31, ob = rr * 64 + cc * 2; return st * 1024 + (ob ^ (((ob >> 9) & 1) << 5)); }
__host__ __device__ __forceinline__ void stage_rc(int b, int& R, int& C) { const int st = b / 1024, sb = b % 1024, swz = sb ^ (((sb >> 9) & 1) << 5); R = (st >> 1) * 16 + swz / 64; C = (st & 1) * 32 + (swz % 64) / 2; }
__host__ __device__ __forceinline__ int perm32(int rho) { const int n = rho >> 4, i = rho & 15; return 8 * (i >> 2) + 4 * n + (i & 3); }

struct Unit { int pm, pn; };
struct Gemm { const bf16_t* A; const bf16_t* Bt; int M, N, K; };

struct StaticOrder {
    int nM, nN, nwg, G, c;
    __host__ __device__ void init(int M, int N, int G_, int c_) { nM = M / BM; nN = N / BM; nwg = nM * nN; G = G_; c = c_; }
    __host__ __device__ bool next(int i, Unit& u) const {
        const long L = (long)i * G + c; if (L >= nwg) return false;
        int wgid = (int)L; { const int q = nwg / NXCD, r = nwg % NXCD, xcd = wgid % NXCD, off = wgid / NXCD; wgid = (xcd < r ? xcd * (q + 1) : r * (q + 1) + (xcd - r) * q) + off; }
        const int nig = WGM * nN, gid = wgid / nig, fm = gid * WGM, gsz = (nM - fm) < WGM ? (nM - fm) : WGM;
        u.pm = fm + ((wgid % nig) % gsz); u.pn = (wgid % nig) / gsz; return true;
    }
    __device__ __forceinline__ void a_ready(const Unit&) const {}
    __device__ __forceinline__ void done(const Unit&) const {}
};

typedef float pg8_f32x2_t __attribute__((ext_vector_type(2))); typedef __bf16 pg8_bf16x2_t __attribute__((ext_vector_type(2)));
__device__ __forceinline__ unsigned cvt_pk_bf16(float lo, float hi) { pg8_f32x2_t v = {lo, hi}; pg8_bf16x2_t b = __builtin_convertvector(v, pg8_bf16x2_t); return __builtin_bit_cast(unsigned, b); }
typedef float f32x2 __attribute__((ext_vector_type(2)));
typedef unsigned u32x2 __attribute__((ext_vector_type(2)));
__device__ __forceinline__ float bflo(unsigned w) { return __uint_as_float(w << 16); }
__device__ __forceinline__ float bfhi(unsigned w) { return __uint_as_float(w & 0xffff0000u); }
__device__ __forceinline__ float sigm(float x) { return __builtin_amdgcn_rcpf(1.f + __expf(-x)); }

struct EpiProj {
    static constexpr bool PERM = true, AFTER_DRAIN = false; static constexpr int MID_T = 0; static constexpr bool HAS_PRE = false;
    bf16_t *Q, *KV, *U, *CB, *GA, *GB, *GN, *VT;
    static __device__ __forceinline__ u32x4 pack(const f32x4& v0, const f32x4& v1) { u32x4 w; w.x = cvt_pk_bf16(v0[0], v0[1]); w.y = cvt_pk_bf16(v0[2], v0[3]); w.z = cvt_pk_bf16(v1[0], v1[1]); w.w = cvt_pk_bf16(v1[2], v1[3]); return w; }
    __device__ __forceinline__ void plain(const f32x4 (&acc)[2][2][4][2], bf16_t* base, int ldc, int row0, int col0) const {
#pragma unroll
        for (int ai = 0; ai < 2; ++ai)
#pragma unroll
            for (int m = 0; m < 4; ++m) {
                bf16_t* rowp = base + (size_t)(row0 + ai * HALF + m * 16) * ldc + col0;
#pragma unroll
                for (int bj = 0; bj < 2; ++bj) *(u32x4*)(rowp + bj * HALF) = pack(acc[ai][bj][m][0], acc[ai][bj][m][1]);
            }
    }
    __device__ __forceinline__ void operator()(const f32x4 (&acc)[2][2][4][2], const Unit& u, int wr, int wc, int fr, int fq) const {
        const int pn = u.pn, row0 = u.pm * BM + wr * 64 + fr, cw = wc * 32 + 8 * fq;
        if (pn < 2) plain(acc, Q, 512, row0, pn * 256 + cw);
        else if (pn == 2) plain(acc, KV, 768, row0, cw);
        else if (pn < 5) {
#pragma unroll
            for (int ai = 0; ai < 2; ++ai)
#pragma unroll
                for (int m = 0; m < 4; ++m) {
                    const int row = row0 + ai * HALF + m * 16;
                    *(u32x4*)(KV + (size_t)row * 768 + (pn - 2) * 256 + cw) = pack(acc[ai][0][m][0], acc[ai][0][m][1]);
                    const u32x4 w = pack(acc[ai][1][m][0], acc[ai][1][m][1]);
                    bf16_t* vt = VT + ((size_t)((((row >> 12) * 2 + (pn - 3)) * 2 + (wc >> 1)) * 64 + (wc & 1) * 32 + 8 * fq)) * 4096 + (row & 4095);
                    vt[0 * 4096] = (bf16_t)(w.x & 0xffffu); vt[1 * 4096] = (bf16_t)(w.x >> 16); vt[2 * 4096] = (bf16_t)(w.y & 0xffffu); vt[3 * 4096] = (bf16_t)(w.y >> 16);
                    vt[4 * 4096] = (bf16_t)(w.z & 0xffffu); vt[5 * 4096] = (bf16_t)(w.z >> 16); vt[6 * 4096] = (bf16_t)(w.w & 0xffffu); vt[7 * 4096] = (bf16_t)(w.w >> 16);
                }
        } else if (pn < 13) {
#pragma unroll
            for (int ai = 0; ai < 2; ++ai)
#pragma unroll
                for (int m = 0; m < 4; ++m)
                    *(u32x4*)(U + (size_t)(row0 + ai * HALF + m * 16) * 1024 + (pn - 5) * 128 + cw) = pack(acc[ai][0][m][0] * acc[ai][1][m][0], acc[ai][0][m][1] * acc[ai][1][m][1]);
        } else if (pn < 17) plain(acc, CB, 1024, row0, (pn - 13) * 256 + cw);
        else if (pn < 25) {
#pragma unroll
            for (int ai = 0; ai < 2; ++ai)
#pragma unroll
                for (int m = 0; m < 4; ++m) {
                    f32x4 a0 = acc[ai][0][m][0], a1 = acc[ai][0][m][1], b0 = acc[ai][1][m][0], b1 = acc[ai][1][m][1];
#pragma unroll
                    for (int i = 0; i < 4; ++i) {
                        const float eb0 = 1.f + __expf(-b0[i]), eb1 = 1.f + __expf(-b1[i]), ea0 = 1.f + __expf(-a0[i]), ea1 = 1.f + __expf(-a1[i]);
                        b0[i] = __builtin_amdgcn_rcpf(eb0); b1[i] = __builtin_amdgcn_rcpf(eb1); a0[i] = eb0 * __builtin_amdgcn_rcpf(ea0); a1[i] = eb1 * __builtin_amdgcn_rcpf(ea1); }
                    const size_t off = (size_t)(row0 + ai * HALF + m * 16) * 1024 + (pn - 17) * 128 + cw;
                    __builtin_nontemporal_store(pack(a0, a1), (u32x4*)(GA + off)); __builtin_nontemporal_store(pack(b0, b1), (u32x4*)(GB + off));
                }
        } else if (wc == 0) {
#pragma unroll
            for (int ai = 0; ai < 2; ++ai)
#pragma unroll
                for (int m = 0; m < 4; ++m) {
                    f32x4 v0 = acc[ai][0][m][0], v1 = acc[ai][0][m][1];
#pragma unroll
                    for (int i = 0; i < 4; ++i) { v0[i] = sigm(v0[i]); v1[i] = sigm(v1[i]); }
                    *(u32x4*)(GN + (size_t)(row0 + ai * HALF + m * 16) * 32 + 8 * fq) = pack(v0, v1);
                }
        }
    }
};
struct EpiMix {
    static constexpr bool PERM = true, AFTER_DRAIN = false; static constexpr int MID_T = 8; static constexpr bool HAS_PRE = false;
    const bf16_t* GA; const bf16_t* GB; bf16_t* O; int ldc;
    __device__ __forceinline__ void mid(f32x4 (&acc)[2][2][4][2], const Unit& u, int wr, int wc, int fr, int fq) const {
        int row0 = u.pm * BM + wr * 64 + fr, col0 = u.pn * BM + wc * 32 + 8 * fq;
        asm volatile("" : "+v"(row0), "+v"(col0));
#pragma unroll
        for (int ai = 0; ai < 2; ++ai)
#pragma unroll
            for (int m = 0; m < 4; ++m)
#pragma unroll
                for (int bj = 0; bj < 2; ++bj) {
                    const size_t off = (size_t)(row0 + ai * HALF + m * 16) * ldc + col0 + bj * HALF;
                    const u32x4 a = *(const u32x4*)(GA + off);
                    acc[ai][bj][m][0] *= (f32x4){bflo(a.x), bfhi(a.x), bflo(a.y), bfhi(a.y)}; acc[ai][bj][m][1] *= (f32x4){bflo(a.z), bfhi(a.z), bflo(a.w), bfhi(a.w)};
                }
    }
    __device__ __forceinline__ void operator()(const f32x4 (&acc)[2][2][4][2], const Unit& u, int wr, int wc, int fr, int fq) const {
        const int row0 = u.pm * BM + wr * 64 + fr, col0 = u.pn * BM + wc * 32 + 8 * fq;
        u32x4 g[2][4][2];
#pragma unroll
        for (int ai = 0; ai < 2; ++ai)
#pragma unroll
            for (int m = 0; m < 4; ++m)
#pragma unroll
                for (int bj = 0; bj < 2; ++bj) g[ai][m][bj] = *(const u32x4*)(GB + (size_t)(row0 + ai * HALF + m * 16) * ldc + col0 + bj * HALF);
#pragma unroll
        for (int ai = 0; ai < 2; ++ai)
#pragma unroll
            for (int m = 0; m < 4; ++m)
#pragma unroll
                for (int bj = 0; bj < 2; ++bj) {
                    const size_t off = (size_t)(row0 + ai * HALF + m * 16) * ldc + col0 + bj * HALF;
                    const u32x4 gg = g[ai][m][bj];
                    const f32x4 v0 = acc[ai][bj][m][0], v1 = acc[ai][bj][m][1];
                    u32x4 w;
                    w.x = cvt_pk_bf16(bflo(gg.x) * v0[0], bfhi(gg.x) * v0[1]);
                    w.y = cvt_pk_bf16(bflo(gg.y) * v0[2], bfhi(gg.y) * v0[3]);
                    w.z = cvt_pk_bf16(bflo(gg.z) * v1[0], bfhi(gg.z) * v1[1]);
                    w.w = cvt_pk_bf16(bflo(gg.w) * v1[2], bfhi(gg.w) * v1[3]);
                    *(u32x4*)(O + off) = w;
                }
    }
};
struct EpiX1 {
    static constexpr bool PERM = false, AFTER_DRAIN = false; static constexpr int MID_T = 0; static constexpr bool HAS_PRE = false;
    const float* x; bf16_t* xb; float* rowss;
    __device__ __forceinline__ void operator()(const f32x4 (&acc)[2][2][4][2], const Unit& u, int wr, int wc, int fr, int fq) const {
        const int row0 = u.pm * BM + wr * 64 + fr, col0 = u.pn * BM + wc * 32 + 4 * fq;
        f32x4 xa[2][2][2], xb_[2][2][2];
#define X1_LOAD(dst, g) do { _Pragma("unroll") for (int mm = 0; mm < 2; ++mm) _Pragma("unroll") for (int bj = 0; bj < 2; ++bj) _Pragma("unroll") for (int n = 0; n < 2; ++n) \
            dst[mm][bj][n] = *(const f32x4*)(x + (size_t)(row0 + ((g) >> 1) * HALF + (2 * ((g) & 1) + mm) * 16) * 1024 + col0 + bj * HALF + n * 16); } while (0)
#define X1_STORE(src, g) do { _Pragma("unroll") for (int mm = 0; mm < 2; ++mm) { const int ai = (g) >> 1, m = 2 * ((g) & 1) + mm, row = row0 + ai * HALF + m * 16; float ss = 0.f; \
            _Pragma("unroll") for (int bj = 0; bj < 2; ++bj) _Pragma("unroll") for (int n = 0; n < 2; ++n) { const size_t off = (size_t)row * 1024 + col0 + bj * HALF + n * 16; \
                const f32x4 vv = src[mm][bj][n] + acc[ai][bj][m][n]; ss += (vv[0] * vv[0] + vv[1] * vv[1]) + (vv[2] * vv[2] + vv[3] * vv[3]); \
                u32x2 w; w.x = cvt_pk_bf16(vv[0], vv[1]); w.y = cvt_pk_bf16(vv[2], vv[3]); *(u32x2*)(xb + off) = w; } \
            ss += __shfl_xor(ss, 16); ss += __shfl_xor(ss, 32); if (fq == 0) atomicAdd(rowss + row, ss); } } while (0)
        X1_LOAD(xa, 0); X1_LOAD(xb_, 1);
        X1_STORE(xa, 0); X1_LOAD(xa, 2);
        X1_STORE(xb_, 1); X1_LOAD(xb_, 3);
        X1_STORE(xa, 2);
        X1_STORE(xb_, 3);
#undef X1_LOAD
#undef X1_STORE
    }
};
struct EpiUp {
    static constexpr bool PERM = true, AFTER_DRAIN = false; static constexpr int MID_T = 0; static constexpr bool HAS_PRE = true;
    const float* rowss; bf16_t* H; int ldc;
    mutable float rsv[2][4];
    __device__ __forceinline__ void pre(const Unit& u, int wr, int fr) const {
        const int row0 = u.pm * BM + wr * 64 + fr;
#pragma unroll
        for (int ai = 0; ai < 2; ++ai)
#pragma unroll
            for (int m = 0; m < 4; ++m) rsv[ai][m] = rowss[row0 + ai * HALF + m * 16];
    }
    __device__ __forceinline__ void operator()(const f32x4 (&acc)[2][2][4][2], const Unit& u, int wr, int wc, int fr, int fq) const {
        const int row0 = u.pm * BM + wr * 64 + fr, col0 = u.pn * BM + wc * 32 + 8 * fq;
#pragma unroll
        for (int ai = 0; ai < 2; ++ai)
#pragma unroll
            for (int m = 0; m < 4; ++m) {
                const int row = row0 + ai * HALF + m * 16;
                const float rs = __builtin_amdgcn_rsqf(rsv[ai][m] * (1.0f / 1024.0f) + 1e-6f);
#pragma unroll
                for (int bj = 0; bj < 2; ++bj) {
                    f32x4 v0 = acc[ai][bj][m][0] * rs, v1 = acc[ai][bj][m][1] * rs;
#pragma unroll
                    for (int i = 0; i < 4; ++i) { const float a = fmaxf(v0[i], 0.f), b = fmaxf(v1[i], 0.f); v0[i] = a * a; v1[i] = b * b; }
                    u32x4 w; w.x = cvt_pk_bf16(v0[0], v0[1]); w.y = cvt_pk_bf16(v0[2], v0[3]); w.z = cvt_pk_bf16(v1[0], v1[1]); w.w = cvt_pk_bf16(v1[2], v1[3]);
                    *(u32x4*)(H + (size_t)row * ldc + col0 + bj * HALF) = w;
                }
            }
    }
};
struct EpiDown {
    static constexpr bool PERM = false, AFTER_DRAIN = false; static constexpr int MID_T = 0; static constexpr bool HAS_PRE = false;
    const bf16_t* xb; float* out;
    __device__ __forceinline__ void operator()(const f32x4 (&acc)[2][2][4][2], const Unit& u, int wr, int wc, int fr, int fq) const {
        const int row0 = u.pm * BM + wr * 64 + fr, col0 = u.pn * BM + wc * 32 + 4 * fq;
        u32x2 xr[2][4][2][2];
#pragma unroll
        for (int ai = 0; ai < 2; ++ai)
#pragma unroll
            for (int m = 0; m < 4; ++m)
#pragma unroll
                for (int bj = 0; bj < 2; ++bj)
#pragma unroll
                    for (int n = 0; n < 2; ++n) xr[ai][m][bj][n] = *(const u32x2*)(xb + (size_t)(row0 + ai * HALF + m * 16) * 1024 + col0 + bj * HALF + n * 16);
#pragma unroll
        for (int ai = 0; ai < 2; ++ai)
#pragma unroll
            for (int m = 0; m < 4; ++m)
#pragma unroll
                for (int bj = 0; bj < 2; ++bj)
#pragma unroll
                    for (int n = 0; n < 2; ++n) { const u32x2 xw = xr[ai][m][bj][n];
                        *(f32x4*)(out + (size_t)(row0 + ai * HALF + m * 16) * 1024 + col0 + bj * HALF + n * 16) = (f32x4){bflo(xw.x), bfhi(xw.x), bflo(xw.y), bfhi(xw.y)} + acc[ai][bj][m][n]; }
    }
};
template <class Epi, class Sched, bool ALIGN_EPI = false, bool SP2 = false>
__device__ __forceinline__ void gemm_phase(PG8_LAS unsigned char* lds, const Gemm g, const Sched& S, const Epi& E) {
    int tid_ = threadIdx.x; asm volatile("" : "+v"(tid_));
    const int tid = tid_, wid = __builtin_amdgcn_readfirstlane(tid >> 6), lane = tid & 63, wr = wid >> 2, wc = wid & 3, fr = lane & 15, fq = lane >> 4;
    const int K = g.K, nt = K / BK;
    unsigned voffA[2], voffB[2];
#pragma unroll
    for (int i = 0; i < 2; ++i) { int R, C; stage_rc(tid * 16 + i * 8192, R, C); const int Rb = Epi::PERM ? ((R & ~31) + perm32(R & 31)) : R;
        voffA[i] = (unsigned)(R * K + C) * 2u; voffB[i] = (unsigned)(Rb * K + C) * 2u; }
    const size_t kstep = (size_t)(BK * 2);
    const size_t hstep = (size_t)HALF * K * 2;
    const size_t tstep = 2 * hstep;
    const unsigned ldsw = (unsigned)wid * 1024u;
    const int aoff = lds_byte(wr * 64 + fr, fq * 8), boff = lds_byte(wc * 32 + fr, fq * 8);
#define PG8_SA(b, h) (((b) * 2 + (h)) * HTB)
#define PG8_SB(b, h) ((4 + (b) * 2 + (h)) * HTB)
#define PG8_STAGE(bufoff, gbase, voff) do { _Pragma("unroll") for (int _i = 0; _i < 2; ++_i) \
        __builtin_amdgcn_global_load_lds((const unsigned*)((const char*)(gbase) + (voff)[_i]), (PG8_LAS unsigned*)(lds + (bufoff) + ldsw + _i * 8192), 16, 0, 0); } while (0)
#define PG8_LDA(dst, b, h) do { _Pragma("unroll") for (int m = 0; m < 4; ++m) _Pragma("unroll") for (int k = 0; k < 2; ++k) dst[m][k] = *(const PG8_LAS bf16x8*)(lds + PG8_SA(b, h) + aoff + m * 2048 + k * 1024); } while (0)
#define PG8_LDB(dst, b, h) do { _Pragma("unroll") for (int n = 0; n < 2; ++n) _Pragma("unroll") for (int k = 0; k < 2; ++k) dst[n][k] = *(const PG8_LAS bf16x8*)(lds + PG8_SB(b, h) + boff + n * 2048 + k * 1024); } while (0)
#define PG8_MMA(ai, bj, At, Bt) do { __builtin_amdgcn_s_setprio(1); _Pragma("unroll") for (int m = 0; m < 4; ++m) _Pragma("unroll") for (int n = 0; n < 2; ++n) _Pragma("unroll") for (int k = 0; k < 2; ++k) \
        acc[ai][bj][m][n] = __builtin_amdgcn_mfma_f32_16x16x32_bf16(Bt[n][k], At[m][k], acc[ai][bj][m][n], 0, 0, 0); __builtin_amdgcn_s_setprio(0); } while (0)
#define PG8_WAIT_V(n) asm volatile("s_waitcnt vmcnt(" #n ")" ::: "memory")
#define PG8_WAIT_L(n) asm volatile("s_waitcnt lgkmcnt(" #n ")" ::: "memory")
#define PG8_BAR __builtin_amdgcn_s_barrier()
#define PG8_SCHED __builtin_amdgcn_sched_barrier(0)
    Unit cur, nxt; int ui = 0;
    if (!S.next(0, cur)) return;
    f32x4 acc[2][2][4][2];
#pragma unroll
    for (int a = 0; a < 2; ++a)
#pragma unroll
        for (int b = 0; b < 2; ++b)
#pragma unroll
            for (int m = 0; m < 4; ++m)
#pragma unroll
                for (int n = 0; n < 2; ++n) acc[a][b][m][n] = (f32x4){0.f, 0.f, 0.f, 0.f};
    bf16x8 At[4][2], B0[2][2], B1[2][2];
    const char* cA = (const char*)g.A + (size_t)cur.pm * tstep; const char* cB = (const char*)g.Bt + (size_t)cur.pn * tstep;
    S.a_ready(cur);
    if constexpr (SP2) {
        PG8_STAGE(PG8_SB(0, 0), cB, voffB); PG8_STAGE(PG8_SB(0, 1), cB + hstep, voffB); PG8_STAGE(PG8_SA(0, 0), cA, voffA); PG8_STAGE(PG8_SA(0, 1), cA + hstep, voffA);
        if (wr == 1) PG8_BAR;
        PG8_WAIT_V(2); PG8_BAR;
        PG8_STAGE(PG8_SB(1, 0), cB + kstep, voffB); PG8_STAGE(PG8_SA(1, 0), cA + kstep, voffA); PG8_STAGE(PG8_SB(1, 1), cB + hstep + kstep, voffB);
        PG8_WAIT_V(6); PG8_BAR;
    } else {
        PG8_STAGE(PG8_SB(0, 0), cB, voffB); PG8_STAGE(PG8_SA(0, 0), cA, voffA); PG8_STAGE(PG8_SB(0, 1), cB + hstep, voffB); PG8_STAGE(PG8_SA(0, 1), cA + hstep, voffA);
        if (wr == 1) PG8_BAR;
        PG8_WAIT_V(4); PG8_BAR;
        PG8_STAGE(PG8_SB(1, 0), cB + kstep, voffB); PG8_STAGE(PG8_SA(1, 0), cA + kstep, voffA); PG8_STAGE(PG8_SB(1, 1), cB + hstep + kstep, voffB);
        PG8_WAIT_V(6); PG8_BAR;
    }
    for (;;) {
        const bool has_next = S.next(ui + 1, nxt);
        const char* nA = has_next ? (const char*)g.A + (size_t)nxt.pm * tstep : cA; const char* nB = has_next ? (const char*)g.Bt + (size_t)nxt.pn * tstep : cB;
        for (int t = 0; t < nt; t += 2) {
            if constexpr (Epi::MID_T > 0) { if (t == Epi::MID_T) E.mid(acc, cur, wr, wc, fr, fq); }
            const bool last = (t == nt - 2);
            const char* a1 = cA + (size_t)(t + 1) * kstep;
            const char* a2 = last ? nA : cA + (size_t)(t + 2) * kstep; const char* b2 = last ? nB : cB + (size_t)(t + 2) * kstep;
            const char* a3 = a2 + kstep; const char* b3 = b2 + kstep;
            if (last && has_next) S.a_ready(nxt);
            if constexpr (Epi::HAS_PRE) { if (last) E.pre(cur, wr, fr); }
            if constexpr (SP2) {
            PG8_LDB(B0, 0, 0); PG8_LDB(B1, 0, 1); PG8_SCHED; PG8_LDA(At, 0, 0); PG8_STAGE(PG8_SA(1, 1), a1 + hstep, voffA);
            PG8_WAIT_V(8); PG8_WAIT_L(0); PG8_BAR; PG8_MMA(0, 0, At, B0); PG8_MMA(0, 1, At, B1); PG8_BAR; PG8_SCHED;
            PG8_LDA(At, 0, 1); PG8_STAGE(PG8_SB(0, 0), b2, voffB); PG8_STAGE(PG8_SB(0, 1), b2 + hstep, voffB); PG8_STAGE(PG8_SA(0, 0), a2, voffA);
            PG8_WAIT_V(8); PG8_WAIT_L(0); PG8_BAR; PG8_MMA(1, 0, At, B0); PG8_MMA(1, 1, At, B1); PG8_BAR; PG8_SCHED;
            PG8_LDB(B0, 1, 0); PG8_LDB(B1, 1, 1); PG8_SCHED; PG8_LDA(At, 1, 0); PG8_STAGE(PG8_SA(0, 1), a2 + hstep, voffA);
            PG8_WAIT_V(8); PG8_WAIT_L(0); PG8_BAR; PG8_MMA(0, 0, At, B0); PG8_MMA(0, 1, At, B1); PG8_BAR; PG8_SCHED;
            PG8_LDA(At, 1, 1); PG8_STAGE(PG8_SB(1, 0), b3, voffB); PG8_STAGE(PG8_SB(1, 1), b3 + hstep, voffB); PG8_STAGE(PG8_SA(1, 0), a3, voffA);
            PG8_WAIT_V(8); PG8_WAIT_L(0); PG8_BAR; PG8_MMA(1, 0, At, B0); PG8_MMA(1, 1, At, B1); PG8_BAR; PG8_SCHED;
            } else {
            PG8_LDB(B0, 0, 0); PG8_SCHED; PG8_LDA(At, 0, 0); PG8_STAGE(PG8_SA(1, 1), a1 + hstep, voffA);
            PG8_WAIT_L(8); PG8_BAR; PG8_WAIT_L(0); PG8_MMA(0, 0, At, B0); PG8_BAR; PG8_SCHED;
            PG8_LDB(B1, 0, 1); PG8_STAGE(PG8_SB(0, 0), b2, voffB);
            PG8_BAR; PG8_WAIT_L(0); PG8_MMA(0, 1, At, B1); PG8_BAR;
            PG8_LDA(At, 0, 1); PG8_STAGE(PG8_SA(0, 0), a2, voffA);
            PG8_BAR; PG8_WAIT_L(0); PG8_MMA(1, 0, At, B0); PG8_BAR; PG8_SCHED;
            PG8_STAGE(PG8_SB(0, 1), b2 + hstep, voffB);
            PG8_WAIT_V(6); PG8_BAR; PG8_MMA(1, 1, At, B1); PG8_BAR;
            PG8_LDB(B0, 1, 0); PG8_SCHED; PG8_LDA(At, 1, 0); PG8_STAGE(PG8_SA(0, 1), a2 + hstep, voffA);
            PG8_WAIT_L(8); PG8_BAR; PG8_WAIT_L(0); PG8_MMA(0, 0, At, B0); PG8_BAR; PG8_SCHED;
            PG8_LDB(B1, 1, 1); PG8_STAGE(PG8_SB(1, 0), b3, voffB);
            PG8_BAR; PG8_WAIT_L(0); PG8_MMA(0, 1, At, B1); PG8_BAR;
            PG8_LDA(At, 1, 1); PG8_STAGE(PG8_SA(1, 0), a3, voffA);
            PG8_BAR; PG8_WAIT_L(0); PG8_MMA(1, 0, At, B0); PG8_BAR; PG8_SCHED;
            PG8_STAGE(PG8_SB(1, 1), b3 + hstep, voffB);
            PG8_WAIT_V(6); PG8_BAR; PG8_MMA(1, 1, At, B1); PG8_BAR;
            }
        }
        if constexpr (ALIGN_EPI) { if (wr == 0) PG8_BAR; }
        if constexpr (!Epi::AFTER_DRAIN) { E(acc, cur, wr, wc, fr, fq); S.done(cur); }
        if (!has_next) break;
#pragma unroll
        for (int a = 0; a < 2; ++a)
#pragma unroll
            for (int b = 0; b < 2; ++b)
#pragma unroll
                for (int m = 0; m < 4; ++m)
#pragma unroll
                    for (int n = 0; n < 2; ++n) acc[a][b][m][n] = (f32x4){0.f, 0.f, 0.f, 0.f};
        cur = nxt; cA = nA; cB = nB; ++ui;
        if constexpr (ALIGN_EPI) { if (wr == 1) PG8_BAR; }
    }
    PG8_WAIT_V(0);
    if constexpr (!ALIGN_EPI) { if (wr == 0) PG8_BAR; }
    PG8_BAR;
    if constexpr (Epi::AFTER_DRAIN) { E.fused(acc, cur, wr, wc, fr, fq, lds, wid, lane); S.done(cur); }
#undef PG8_SA
#undef PG8_SB
#undef PG8_STAGE
#undef PG8_LDA
#undef PG8_LDB
#undef PG8_MMA
#undef PG8_WAIT_V
#undef PG8_WAIT_L
#undef PG8_BAR
#undef PG8_SCHED
}
}

constexpr int BATCH = 8, SEQ = 4096, DM = 1024, M = BATCH * SEQ, NPROJ = 6424, NPAD = 6656, DFF = 4096;
constexpr float EPS = 1e-6f, LOG2E = 1.4426950408889634f;
constexpr int NWAVES = 8;
constexpr size_t MiB = 1u << 20;
constexpr size_t WS_ROWSS = 0;
constexpr size_t WS_WIN = 2 * MiB, WS_WAB = 15 * MiB  , WS_WO = 18 * MiB, WS_WUP = 20 * MiB, WS_WDN = 28 * MiB;
constexpr size_t WS_WC = 36 * MiB;
constexpr size_t WS_POSB = 36 * MiB + 512 * 1024;
constexpr size_t WS_KCN = 37 * MiB;
constexpr size_t WS_VCT = 38 * MiB;
constexpr size_t WS_VT = 480 * MiB;
constexpr size_t WS_GN = 43 * MiB;
constexpr size_t WS_XN = 48 * MiB;
constexpr size_t WS_Q = 112 * MiB;
constexpr size_t WS_KV = 144 * MiB;
constexpr size_t WS_U = 192 * MiB;
constexpr size_t WS_CB = 256 * MiB;
constexpr size_t WS_ZO = 320 * MiB;
constexpr size_t WS_MIX = 112 * MiB;
constexpr size_t WS_H = 192 * MiB;
constexpr size_t WS_END = 496 * MiB;
constexpr int RING_BYTES = 131072, LDS_BYTES = 147456, MISC_OFF = RING_BYTES + 320;
constexpr size_t WS_BAR = 1 * MiB;

#define LAS __attribute__((address_space(3)))
typedef unsigned short bf16;
typedef unsigned v4u __attribute__((ext_vector_type(4)));
typedef unsigned v2u __attribute__((ext_vector_type(2)));
typedef float f32x4 __attribute__((ext_vector_type(4)));
typedef float f32x16 __attribute__((ext_vector_type(16)));
typedef short bf16x8 __attribute__((ext_vector_type(8)));
typedef short s16x4 __attribute__((ext_vector_type(4)));
typedef float f32x2_t __attribute__((ext_vector_type(2)));
typedef __bf16 bf16x2_t __attribute__((ext_vector_type(2)));
#define LDS_WAIT() asm volatile("s_waitcnt lgkmcnt(0)" ::: "memory")
#define MFMA32(a, b, c) __builtin_amdgcn_mfma_f32_32x32x16_bf16(a, b, c, 0, 0, 0)
__device__ __forceinline__ unsigned pk2(float lo, float hi) { f32x2_t v = {lo, hi}; bf16x2_t b = __builtin_convertvector(v, bf16x2_t); return __builtin_bit_cast(unsigned, b); }
__device__ __forceinline__ float bf2f(bf16 h) { return __uint_as_float((unsigned)h << 16); }
__device__ __forceinline__ float blo(unsigned w) { return __uint_as_float(w << 16); }
__device__ __forceinline__ float bhi(unsigned w) { return __uint_as_float(w & 0xffff0000u); }
__device__ __forceinline__ bf16x8 pack8(float a0, float a1, float a2, float a3, float a4, float a5, float a6, float a7) {
    v4u w; w.x = pk2(a0, a1); w.y = pk2(a2, a3); w.z = pk2(a4, a5); w.w = pk2(a6, a7); return __builtin_bit_cast(bf16x8, w); }
__device__ __forceinline__ int crow(int r, int hi) { return (r & 3) + 8 * (r >> 2) + 4 * hi; }
__device__ __forceinline__ float ex2(float x) { return __builtin_amdgcn_exp2f(x); }

struct Args {
    const float *x, *norm1_g, *w_in, *q_norm_g, *k_norm_g, *cmp_pos_k, *cmp_pos_v, *w_cmp_k, *w_cmp_v, *conv_w, *w_branch_a, *w_branch_b, *w_out, *norm2_g, *w_up, *w_down;
    float* out; unsigned char* ws;
    int never; int pad;
};

#define XB_TMO      128
#define XB_XCNT(j)  (256  + 64 * (j))
#define XB_XSUB(j)  (1280 + 64 * (j))
#define XB_XGEN(j)  (2304 + 64 * (j))
#define XB_TOP      3328
#define XB_TOPGEN   3392
#define XCD_BAR_WORDS 3456
#define XB_SPIN_CAP (1u << 18)

__device__ __forceinline__ unsigned xb_ld(unsigned* p)              { return __hip_atomic_load(p, __ATOMIC_RELAXED, __HIP_MEMORY_SCOPE_AGENT); }
__device__ __forceinline__ unsigned xb_add(unsigned* p, unsigned v) { return __hip_atomic_fetch_add(p, v, __ATOMIC_RELAXED, __HIP_MEMORY_SCOPE_AGENT); }
__device__ __forceinline__ unsigned xb_xcc_id() { return (unsigned)__builtin_amdgcn_s_getreg((3 << 11) | 20) & 0xFu; }
#define XB_SPIN(cond, bar) do { unsigned _sp = 0; while (cond) { __builtin_amdgcn_s_sleep(1); \
    if ((++_sp & 255u) == 0u) { if (xb_ld(&(bar)[XB_TMO])) break; if (_sp > XB_SPIN_CAP) { atomicAdd(&(bar)[XB_TMO], 1u); break; } } } } while (0)

struct XcdBarrier {
    unsigned* bar; unsigned x;
    volatile LAS unsigned* st;
};

__device__ __forceinline__ XcdBarrier xcd_barrier_post(unsigned* bar, volatile LAS unsigned* st) {
    XcdBarrier b; b.bar = bar; b.x = xb_xcc_id(); b.st = st;
    if (threadIdx.x == 0) (void)xb_add(&bar[XB_XCNT(b.x)], 1u);
    return b;
}
__device__ __forceinline__ void xcd_barrier_complete(unsigned* bar, unsigned x, unsigned& nloc, unsigned& nx) {
    const unsigned G = gridDim.x * gridDim.y * gridDim.z;
    unsigned sum, cnt, mine, sp = 0u;
    for (;;) {
        sum = 0u; cnt = 0u; mine = 0u;
#pragma unroll
        for (unsigned j = 0; j < 16; ++j) { const unsigned c = xb_ld(&bar[XB_XCNT(j)]); sum += c; cnt += (c > 0u) ? 1u : 0u; mine = (j == x) ? c : mine; }
        if (sum == G) break;
        __builtin_amdgcn_s_sleep(1);
        if ((++sp & 255u) == 0u) { if (xb_ld(&bar[XB_TMO])) break; if (sp > XB_SPIN_CAP) { atomicAdd(&bar[XB_TMO], 1u); break; } }
    }
    nloc = mine > 0u ? mine : 1u; nx = cnt > 0u ? cnt : 1u;
}

__device__ __forceinline__ void xcd_barrier(const XcdBarrier& b) {
    asm volatile("s_waitcnt vmcnt(0)" ::: "memory");
    __syncthreads();
    if (threadIdx.x == 0) {
        unsigned* bar = b.bar;
        __builtin_amdgcn_s_waitcnt(0);
        unsigned nloc = b.st[0], nx = b.st[1];
        if (nloc == 0u) { xcd_barrier_complete(bar, b.x, nloc, nx); b.st[0] = nloc; b.st[1] = nx; }
        const unsigned old = xb_add(&bar[XB_XSUB(b.x)], 1u);
        const unsigned gen = old / nloc;
        if (old + 1u == (gen + 1u) * nloc) {
            __builtin_amdgcn_fence(__ATOMIC_RELEASE, "agent");
            asm volatile("s_waitcnt vmcnt(0)" ::: "memory");
            const unsigned og = xb_add(&bar[XB_TOP], 1u);
            const unsigned tg = og / nx;
            if (og + 1u == (tg + 1u) * nx) xb_add(&bar[XB_TOPGEN], 1u);
            else XB_SPIN(xb_ld(&bar[XB_TOPGEN]) == tg, bar);
            __builtin_amdgcn_fence(__ATOMIC_ACQUIRE, "agent");
            xb_add(&bar[XB_XGEN(b.x)], 1u);
            asm volatile("s_waitcnt vmcnt(0)" ::: "memory");
        } else {
            XB_SPIN(xb_ld(&bar[XB_XGEN(b.x)]) == gen, bar);
            __builtin_amdgcn_fence(__ATOMIC_ACQUIRE, "agent");
            asm volatile("s_waitcnt vmcnt(0)" ::: "memory");
        }
    }
    __syncthreads();
}

__device__ __forceinline__ int map_win(int ns) {
    if (ns < 1280) return ns;
    if (ns < 1304) return 6400 + (ns - 1280);
    if (ns < 2328) return 3328 + (ns - 1304);
    if (ns < 3352) { const int ch = ns - 2328; return 1280 + (ch >> 7) * 256 + (ch & 127); }
    if (ns < 4376) { const int ch = ns - 3352; return 1280 + (ch >> 7) * 256 + 128 + (ch & 127); }
    if (ns < 5400) { const int ch = ns - 4376; return 4352 + (ch >> 7) * 256 + (ch & 127); }
    { const int ch = ns - 5400; return 4352 + (ch >> 7) * 256 + 128 + (ch & 127); }
}
template <bool MAP> __device__ __forceinline__ void tr_item(const float* W, int K, int N, bf16* WT, int ldk, const float* kscale, LAS float* scr, int item, int lane) {
    const int nblk = (N + 31) / 32, kb = item / nblk, nb = item % nblk, k0 = 64 * kb, n0 = 32 * nb;
    const int nl = n0 + (lane & 31); const bool nok = nl < N;
    float tv[32];
#pragma unroll
    for (int i = 0; i < 32; ++i) { const int kk = 2 * i + (lane >> 5); tv[i] = nok ? __builtin_nontemporal_load(W + (size_t)(k0 + kk) * N + nl) : 0.f; }
#pragma unroll
    for (int i = 0; i < 32; ++i) { const int kk = 2 * i + (lane >> 5); float v = tv[i]; if (kscale) v *= kscale[k0 + kk]; scr[kk * 33 + (lane & 31)] = v; }
    LDS_WAIT(); asm volatile("" ::: "memory");
    const int c = lane & 7;
#pragma unroll
    for (int j = 0; j < 4; ++j) { const int n = (lane >> 3) + 8 * j, ns = n0 + n; const LAS float* s = scr + (8 * c) * 33 + n;
        if (ns < N) { const int dr = MAP ? map_win(ns) : ns;
            v4u o; o.x = pk2(s[0 * 33], s[1 * 33]); o.y = pk2(s[2 * 33], s[3 * 33]); o.z = pk2(s[4 * 33], s[5 * 33]); o.w = pk2(s[6 * 33], s[7 * 33]);
            *(v4u*)(WT + (size_t)dr * ldk + k0 + 8 * c) = o; } }
    LDS_WAIT(); asm volatile("" ::: "memory");
}
__device__ __forceinline__ float wave_sum(float v) {
#pragma unroll
    for (int o = 1; o < 64; o <<= 1) v += __shfl_xor(v, o);
    return v;
}

constexpr int L_KC = 0, L_VCT = 36864, L_K0 = 70144, L_V0 = 88576, L_SC = 105984, L_MB = 122368;
constexpr int KSTR = 72, VSTR = 68, VCSTR = 260;
static_assert(L_MB + 512 <= RING_BYTES, "attention LDS map");

__device__ __forceinline__ void attn_qk(const LAS unsigned char* Kb, const f32x16& cinit, const bf16x8 (&qf)[4], f32x16& p0, f32x16& p1, int r32, int hi) {
    p0 = cinit; p1 = cinit;
    bf16x8 ka[4], kb[4];
#pragma unroll
    for (int kk = 0; kk < 4; ++kk) {
        ka[kk] = *(const LAS bf16x8*)(Kb + (r32 * KSTR + 16 * kk + 8 * hi) * 2);
        kb[kk] = *(const LAS bf16x8*)(Kb + ((32 + r32) * KSTR + 16 * kk + 8 * hi) * 2);
    }
    __builtin_amdgcn_sched_barrier(0);
#pragma unroll
    for (int kk = 0; kk < 4; ++kk) { p0 = MFMA32(ka[kk], qf[kk], p0); p1 = MFMA32(kb[kk], qf[kk], p1); }
}
template <bool WIN>
__device__ __forceinline__ void attn_sp(const LAS unsigned char* Vb, int j, int cur, int tokl, unsigned long long lmask, float slope2,
                                        f32x16& p0, f32x16& p1, f32x16 (&o)[2], float& m, float& l, int r32, int hi) {
    const bool sel = (lmask >> j) & 1ull;
    const float T0 = slope2 * (float)(64 * j), T1 = T0 + 32.f * slope2;
    if (j == cur || (WIN && j == cur - 8)) {
        const int hl = (j == cur) ? tokl - 4 * hi : 99;
        const int ll = (WIN && j != cur) ? tokl - 4 * hi : -1;
#pragma unroll
        for (int r = 0; r < 16; ++r) {
            const int cr = (r & 3) + 8 * (r >> 2);
            p0[r] = (cr > ll && cr <= hl) ? p0[r] : -1e30f; p1[r] = (cr + 32 > ll && cr + 32 <= hl) ? p1[r] : -1e30f;
        }
    }
    float mx0 = fmaxf(fmaxf(p0[0], p0[1]), p0[2]), mx1 = fmaxf(fmaxf(p1[0], p1[1]), p1[2]);
#pragma unroll
    for (int r = 3; r < 15; r += 2) { mx0 = fmaxf(fmaxf(mx0, p0[r]), p0[r + 1]); mx1 = fmaxf(fmaxf(mx1, p1[r]), p1[r + 1]); }
    mx0 = fmaxf(mx0, p0[15]); mx1 = fmaxf(mx1, p1[15]);
    float bm = sel ? fmaxf(mx0 + T0, mx1 + T1) : -1e30f;
    bm = fmaxf(bm, __shfl_xor(bm, 32));
    if (__builtin_amdgcn_ballot_w64(bm > m - 24.0f) == 0ull) return;
    const float mn = fmaxf(m, bm);
    if (__builtin_amdgcn_ballot_w64(mn > m) != 0ull) {
        const float alpha = ex2(m - mn); l *= alpha;
#pragma unroll
        for (int r = 0; r < 16; ++r) { o[0][r] *= alpha; o[1][r] *= alpha; }
    }
    m = mn;
    const bool live = sel && (mn > -1e29f);
    const float c0 = live ? mn - T0 : 1e30f, c1 = live ? mn - T1 : 1e30f;
    p0 = p0 - c0; p1 = p1 - c1;
#pragma unroll
    for (int r = 0; r < 16; ++r) { p0[r] = ex2(p0[r]); p1[r] = ex2(p1[r]); }
    { const f32x16 ps = p0 + p1; l += ((ps[0] + ps[1]) + (ps[2] + ps[3])) + ((ps[4] + ps[5]) + (ps[6] + ps[7])) + ((ps[8] + ps[9]) + (ps[10] + ps[11])) + ((ps[12] + ps[13]) + (ps[14] + ps[15])); }
#pragma unroll
    for (int j4 = 0; j4 < 4; ++j4) {
        bf16x8 pb;
        if (j4 < 2) pb = pack8(p0[8 * (j4 & 1) + 0], p0[8 * (j4 & 1) + 1], p0[8 * (j4 & 1) + 2], p0[8 * (j4 & 1) + 3], p0[8 * (j4 & 1) + 4], p0[8 * (j4 & 1) + 5], p0[8 * (j4 & 1) + 6], p0[8 * (j4 & 1) + 7]);
        else        pb = pack8(p1[8 * (j4 & 1) + 0], p1[8 * (j4 & 1) + 1], p1[8 * (j4 & 1) + 2], p1[8 * (j4 & 1) + 3], p1[8 * (j4 & 1) + 4], p1[8 * (j4 & 1) + 5], p1[8 * (j4 & 1) + 6], p1[8 * (j4 & 1) + 7]);
#pragma unroll
        for (int d0 = 0; d0 < 2; ++d0) {
            const LAS unsigned char* vp = Vb + ((r32 + 32 * d0) * VSTR + 16 * j4 + 4 * hi) * 2;
            const s16x4 lo4 = *(const LAS s16x4*)vp, hi4 = *(const LAS s16x4*)(vp + 16);
            const bf16x8 a = (bf16x8){lo4[0], lo4[1], lo4[2], lo4[3], hi4[0], hi4[1], hi4[2], hi4[3]};
            o[d0] = MFMA32(a, pb, o[d0]);
        }
    }
}

template <bool WIN>
__device__ __forceinline__ void attn_branch(LAS unsigned char* L, const bf16* kvb, const bf16* vtb, unsigned long long umask, unsigned long long lmask,
                                            int cur, int tokl, float slope2, const f32x16& cinit, const bf16x8 (&qf)[4], f32x16 (&o)[2], float& l_out, int tid, int r32, int hi, bool skew, v4u k_first, v4u v_first) {
    o[0] = f32x16{}; o[1] = f32x16{}; float m = -1e30f, l = 0.f;
    const int srow = tid >> 3, sch = tid & 7;
    unsigned long long pend = umask;
#define POP(dst) do { if (pend) { dst = 63 - __builtin_clzll(pend); pend &= ~(1ull << dst); } else dst = -1; } while (0)
#define STAGE_LOAD(kr, vr, jj) do { kr = *(const v4u*)(kvb + (size_t)(64 * (jj) + srow) * 768 + sch * 8); vr = *(const v4u*)(vtb + (size_t)srow * SEQ + 64 * (jj) + sch * 8); } while (0)
#define STAGE_WRITE(kso, vso, kr, vr) do { \
        *(LAS v4u*)(L + L_K0 + (kso) + (srow * KSTR + sch * 8) * 2) = kr; \
        LAS v2u* vt_ = (LAS v2u*)(L + L_V0 + (vso) + (srow * VSTR + sch * 8) * 2); \
        vt_[0] = (v2u){vr.x, vr.y}; vt_[1] = (v2u){vr.z, vr.w}; } while (0)
    int jq0, jq1; POP(jq0); POP(jq1);
    v4u kA = k_first, vA = v_first;
    STAGE_WRITE(0, 0, kA, vA);
    if (jq1 >= 0) STAGE_LOAD(kA, vA, jq1);
    __syncthreads();
    int kso = 0, vso = 0, vsn = 8704, vsp = 0, jprev = -1;
    f32x16 p0, p1;
    for (;;) {
        int jq2 = -1;
        if (jq1 >= 0) { STAGE_WRITE(kso ^ 9216, vsn, kA, vA); POP(jq2); if (jq2 >= 0) STAGE_LOAD(kA, vA, jq2); }
        if (skew) {
            if (jprev >= 0) attn_sp<WIN>(L + L_V0 + vsp, jprev, cur, tokl, lmask, slope2, p0, p1, o, m, l, r32, hi);
            attn_qk(L + L_K0 + kso, cinit, qf, p0, p1, r32, hi);
        } else {
            attn_qk(L + L_K0 + kso, cinit, qf, p0, p1, r32, hi);
            attn_sp<WIN>(L + L_V0 + vso, jq0, cur, tokl, lmask, slope2, p0, p1, o, m, l, r32, hi);
        }
        __syncthreads();
        jprev = jq0; vsp = vso; vso = vsn; vsn = (vsn == 2 * 8704) ? 0 : vsn + 8704; kso ^= 9216;
        if (jq1 < 0) break;
        jq0 = jq1; jq1 = jq2;
    }
    if (skew) attn_sp<WIN>(L + L_V0 + vsp, jprev, cur, tokl, lmask, slope2, p0, p1, o, m, l, r32, hi);
    __syncthreads();
#undef POP
#undef STAGE_LOAD
#undef STAGE_WRITE
    l_out = l + __shfl_xor(l, 32);
}

struct AttnPtrs { const bf16 *Q, *KV, *GN, *KCN, *VCT, *VT; bf16* O; const float* qg; };

__device__ __forceinline__ void attn_unit(const AttnPtrs& A, LAS unsigned char* L, int b, int g, int cur) {
    int tid_ = threadIdx.x; asm volatile("" : "+v"(tid_));
    const int tid = tid_, lane = tid & 63, w = __builtin_amdgcn_readfirstlane(tid >> 6), r32 = lane & 31, hi = lane >> 5;
    const int tokl = 8 * w + (r32 >> 2), head = r32 & 3, hq = g * 4 + head, t = 64 * cur + tokl;
    const size_t mrow = (size_t)b * SEQ + t;
    const float slope2 = ex2(-(float)(hq + 1)) * LOG2E;
    bf16x8 qf[4];
    {
        const bf16* qp = A.Q + mrow * 512 + hq * 64 + 8 * hi;
        v4u qw[4]; float ss = 0.f;
#pragma unroll
        for (int kk = 0; kk < 4; ++kk) qw[kk] = *(const v4u*)(qp + 16 * kk);
#pragma unroll
        for (int kk = 0; kk < 4; ++kk) { const v4u w_ = qw[kk];
            ss += (blo(w_.x) * blo(w_.x) + bhi(w_.x) * bhi(w_.x)) + (blo(w_.y) * blo(w_.y) + bhi(w_.y) * bhi(w_.y)) + (blo(w_.z) * blo(w_.z) + bhi(w_.z) * bhi(w_.z)) + (blo(w_.w) * blo(w_.w) + bhi(w_.w) * bhi(w_.w)); }
        ss += __shfl_xor(ss, 32);
        const float rq = __builtin_amdgcn_rsqf(ss * (1.f / 64.f) + EPS) * (0.125f * LOG2E);
#pragma unroll
        for (int kk = 0; kk < 4; ++kk) { const v4u w_ = qw[kk]; const f32x4 ga = *(const f32x4*)(A.qg + 16 * kk + 8 * hi), gb = *(const f32x4*)(A.qg + 16 * kk + 8 * hi + 4);
            qf[kk] = pack8(blo(w_.x) * rq * ga[0], bhi(w_.x) * rq * ga[1], blo(w_.y) * rq * ga[2], bhi(w_.y) * rq * ga[3], blo(w_.z) * rq * gb[0], bhi(w_.z) * rq * gb[1], blo(w_.w) * rq * gb[2], bhi(w_.w) * rq * gb[3]); }
    }
    const float g0 = bf2f(A.GN[mrow * 32 + hq]), g1 = bf2f(A.GN[mrow * 32 + 8 + hq]), g2 = bf2f(A.GN[mrow * 32 + 16 + hq]);
    const int ncv = (4 * cur + 3 < 255) ? 4 * cur + 3 : 255, nblk = (ncv + 31) >> 5, nrow = nblk * 32;
    v4u kr[4], vr[4];
    {
        const bf16* kc = A.KCN + (size_t)(b * 2 + g) * 256 * 64; const bf16* vc = A.VCT + (size_t)(b * 2 + g) * 64 * 256;
#pragma unroll
        for (int i = 0; i < 4; ++i) {
            const int ck = i * 512 + tid, row = ck >> 3;
            kr[i] = (row < nrow) ? *(const v4u*)(kc + (size_t)ck * 8) : (v4u){0u, 0u, 0u, 0u};
            const int d = ck >> 5, cc = (ck & 31) * 8;
            vr[i] = (cc < nrow) ? *(const v4u*)(vc + (size_t)d * 256 + cc) : (v4u){0u, 0u, 0u, 0u};
        }
    }
    __syncthreads();
    {
#pragma unroll
        for (int i = 0; i < 4; ++i) {
            const int ck = i * 512 + tid, row = ck >> 3, d = ck >> 5, cc = (ck & 31) * 8;
            if (row < nrow) *(LAS v4u*)(L + L_KC + (row * KSTR + (ck & 7) * 8) * 2) = kr[i];
            if (cc < nrow) { LAS v2u* vp = (LAS v2u*)(L + L_VCT + (d * VCSTR + cc) * 2); vp[0] = (v2u){vr[i].x, vr[i].y}; vp[1] = (v2u){vr[i].z, vr[i].w}; }
        }
    }
    __syncthreads();
    f32x16 cinit;
#pragma unroll
    for (int r = 0; r < 16; ++r) cinit[r] = slope2 * (float)((r & 3) + 8 * (r >> 2) + 4 * hi);
    const int clim_l = ((t - 31) >> 4) - 4 * hi;
    const bool need_imp = cur >= 16;
    LAS f32x4* park = (LAS f32x4*)(L + w * 8192) + lane;
    float imp[33];
#pragma unroll
    for (int i = 0; i < 33; ++i) imp[i] = 0.f;
    {
        f32x16 oc[2]; oc[0] = f32x16{}; oc[1] = f32x16{};
        float m1 = -1e30f, l1 = 0.f;
#pragma unroll
        for (int bi = 0; bi < 8; ++bi) {
            const int blk = 7 - bi;
            if (blk < nblk) {
                f32x16 p = f32x16{};
                { bf16x8 kc4[4];
#pragma unroll
                  for (int kk = 0; kk < 4; ++kk) kc4[kk] = *(const LAS bf16x8*)(L + L_KC + ((32 * blk + r32) * KSTR + 16 * kk + 8 * hi) * 2);
                  __builtin_amdgcn_sched_barrier(0);
#pragma unroll
                  for (int kk = 0; kk < 4; ++kk) p = MFMA32(kc4[kk], qf[kk], p); }
                if (32 * blk + 31 > 4 * cur - 2) {
#pragma unroll
                    for (int r = 0; r < 16; ++r) p[r] = (32 * blk + (r & 3) + 8 * (r >> 2) <= clim_l) ? fmaf(cinit[r], 16.f, p[r]) : -1e30f;
                } else {
#pragma unroll
                    for (int r = 0; r < 16; ++r) p[r] = fmaf(cinit[r], 16.f, p[r]);
                }
                const float Tb = slope2 * 512.f * (float)blk;
                float mx = fmaxf(fmaxf(p[0], p[1]), p[2]);
#pragma unroll
                for (int r = 3; r < 15; r += 2) mx = fmaxf(fmaxf(mx, p[r]), p[r + 1]);
                mx = fmaxf(mx, p[15]);
                float bm = mx + Tb; bm = fmaxf(bm, __shfl_xor(bm, 32));
                const float mn = fmaxf(m1, bm);
                if (__builtin_amdgcn_ballot_w64(mn > m1) != 0ull) {
                    const float alpha = ex2(m1 - mn); l1 *= alpha;
#pragma unroll
                    for (int r = 0; r < 16; ++r) { oc[0][r] *= alpha; oc[1][r] *= alpha; }
                    if (need_imp) {
#pragma unroll
                        for (int i = 0; i < 33; ++i) imp[i] *= alpha;
                    }
                }
                m1 = mn;
                const float c2 = (mn > -1e29f) ? mn - Tb : 1e30f;
                float rs = 0.f;
#pragma unroll
                for (int r = 0; r < 16; ++r) { p[r] = ex2(p[r] - c2); rs += p[r]; }
                l1 += rs;
                if (need_imp) {
#pragma unroll
                    for (int a = 0; a < 4; ++a) {
                        const float sp = 0.5f * p[4 * a + 3], v = p[4 * a] + p[4 * a + 1] + p[4 * a + 2] + sp, rc = __shfl_xor(sp, 32);
                        imp[4 * blk + a] += v + (hi ? rc : 0.f); imp[4 * blk + a + 1] += (hi ? 0.f : rc);
                    }
                }
#pragma unroll
                for (int j2 = 0; j2 < 2; ++j2) {
                    const bf16x8 pb = pack8(p[8 * j2 + 0], p[8 * j2 + 1], p[8 * j2 + 2], p[8 * j2 + 3], p[8 * j2 + 4], p[8 * j2 + 5], p[8 * j2 + 6], p[8 * j2 + 7]);
#pragma unroll
                    for (int d0 = 0; d0 < 2; ++d0) {
                        const LAS unsigned char* vp = L + L_VCT + ((r32 + 32 * d0) * VCSTR + 32 * blk + 16 * j2 + 4 * hi) * 2;
                        const s16x4 lo4 = *(const LAS s16x4*)vp, hi4 = *(const LAS s16x4*)(vp + 16);
                        const bf16x8 a = (bf16x8){lo4[0], lo4[1], lo4[2], lo4[3], hi4[0], hi4[1], hi4[2], hi4[3]};
                        oc[d0] = MFMA32(a, pb, oc[d0]);
                    }
                }
            }
        }
        const float Lt = l1 + __shfl_xor(l1, 32), inv = 1.0f / fmaxf(Lt, 1e-30f), gi = g0 * inv;
        __syncthreads();
#pragma unroll
        for (int k = 0; k < 4; ++k) {
            park[64 * k] = (f32x4){gi * oc[0][4 * k], gi * oc[0][4 * k + 1], gi * oc[0][4 * k + 2], gi * oc[0][4 * k + 3]};
            park[64 * (4 + k)] = (f32x4){gi * oc[1][4 * k], gi * oc[1][4 * k + 1], gi * oc[1][4 * k + 2], gi * oc[1][4 * k + 3]};
        }
        if (need_imp) {
#pragma unroll
            for (int i = 0; i < 32; ++i) imp[i] *= inv;
        }
    }
    const bf16* kvb = A.KV + (size_t)b * SEQ * 768 + g * 64;
    const bf16* vts = A.VT + (size_t)((b * 2 + 0) * 2 + g) * 64 * SEQ; const bf16* vtw = A.VT + (size_t)((b * 2 + 1) * 2 + g) * 64 * SEQ;
    const v4u ks0 = *(const v4u*)(kvb + 256 + (size_t)(64 * cur + (tid >> 3)) * 768 + (tid & 7) * 8), vs0 = *(const v4u*)(vts + (size_t)(tid >> 3) * SEQ + 64 * cur + (tid & 7) * 8);
    const unsigned long long causal = (cur >= 63) ? ~0ull : ((2ull << cur) - 1ull);
    unsigned long long lmask = causal, umask = causal;
    if (cur >= 16) {
#pragma unroll
        for (int i = 0; i < 32; ++i) { imp[i] += __shfl_xor(imp[i], 1); imp[i] += __shfl_xor(imp[i], 2); }
        if (head == 0) {
            LAS unsigned* sc = (LAS unsigned*)(L + L_SC) + tokl * 64 + hi;
#pragma unroll
            for (int i = 0; i < 32; ++i) { const int jj = 2 * i + hi; const bool forced = (jj == 0) || (jj == cur) || (jj == cur - 1);
                const unsigned kb = forced ? __float_as_uint(1e4f) : ((jj <= cur) ? __float_as_uint(imp[i]) : 0u); sc[2 * i] = (kb & ~63u) | (unsigned)(63 - jj); }
        }
        __syncthreads();
        {
            const int tok = tid >> 3, part = tid & 7; const LAS unsigned* row = (const LAS unsigned*)(L + L_SC) + tok * 64;
            unsigned mine[8]; int rank[8];
#pragma unroll
            for (int e = 0; e < 8; ++e) { mine[e] = row[part * 8 + e]; rank[e] = 0; }
            for (int jj = 0; jj <= cur; jj += 4) {
                const v4u k4 = *(const LAS v4u*)(row + jj);
#pragma unroll
                for (int q = 0; q < 4; ++q) {
#pragma unroll
                    for (int e = 0; e < 8; ++e) rank[e] += (k4[q] > mine[e]) ? 1 : 0;
                }
            }
            unsigned bits = 0u;
#pragma unroll
            for (int e = 0; e < 8; ++e) bits |= (rank[e] < 16 ? 1u : 0u) << e;
            ((LAS unsigned char*)(L + L_MB))[tok * 8 + part] = (unsigned char)bits;
        }
        __syncthreads();
        const v2u mw = *(const LAS v2u*)(L + L_MB + tokl * 8);
        lmask = (((unsigned long long)mw.y << 32) | mw.x) & causal;
        v2u uw = *(const LAS v2u*)(L + L_MB + lane * 8);
#pragma unroll
        for (int o_ = 1; o_ < 64; o_ <<= 1) { uw.x |= (unsigned)__shfl_xor((int)uw.x, o_); uw.y |= (unsigned)__shfl_xor((int)uw.y, o_); }
        umask = ((((unsigned long long)(unsigned)__builtin_amdgcn_readfirstlane((int)uw.y)) << 32) | (unsigned)__builtin_amdgcn_readfirstlane((int)uw.x)) & causal;
    }
    v4u kw0, vw0;
    {
        f32x16 o[2]; float lt;
        attn_branch<false>(L, kvb + 256, vts, umask, lmask, cur, tokl, slope2, cinit, qf, o, lt, tid, r32, hi, false, ks0, vs0);
        kw0 = *(const v4u*)(kvb + 512 + (size_t)(64 * cur + (tid >> 3)) * 768 + (tid & 7) * 8); vw0 = *(const v4u*)(vtw + (size_t)(tid >> 3) * SEQ + 64 * cur + (tid & 7) * 8);
        const float sc = g1 / lt;
#pragma unroll
        for (int k = 0; k < 4; ++k) {
            park[64 * k] += (f32x4){sc * o[0][4 * k], sc * o[0][4 * k + 1], sc * o[0][4 * k + 2], sc * o[0][4 * k + 3]};
            park[64 * (4 + k)] += (f32x4){sc * o[1][4 * k], sc * o[1][4 * k + 1], sc * o[1][4 * k + 2], sc * o[1][4 * k + 3]};
        }
    }
    {
        const int jlo = (cur >= 8) ? cur - 8 : 0;
        const unsigned long long wmask = causal & ~((1ull << jlo) - 1ull);
        f32x16 o[2]; float lt;
                attn_branch<true>(L, kvb + 512, vtw, wmask, ~0ull, cur, tokl, slope2, cinit, qf, o, lt, tid, r32, hi, false, kw0, vw0);
        const float sc = g2 / lt;
        bf16* op = A.O + mrow * 1536 + hq * 64 + 4 * hi;
#pragma unroll
        for (int d0 = 0; d0 < 2; ++d0)
#pragma unroll
            for (int a = 0; a < 4; ++a) {
                const f32x4 pv = park[64 * (4 * d0 + a)];
                v2u wv; wv.x = pk2(pv[0] + sc * o[d0][4 * a], pv[1] + sc * o[d0][4 * a + 1]); wv.y = pk2(pv[2] + sc * o[d0][4 * a + 2], pv[3] + sc * o[d0][4 * a + 3]);
                *(v2u*)(op + 32 * d0 + 8 * a) = wv;
            }
    }
}

__global__ void __launch_bounds__(NWAVES * 64, 2) nsa_block_fwd(Args a) {
    extern __shared__ __attribute__((aligned(16))) unsigned char lds_raw[];
    cg::grid_group grid = cg::this_grid();
    LAS unsigned char* lds = (LAS unsigned char*)lds_raw;
    const int tid = threadIdx.x, lane = tid & 63, wave = __builtin_amdgcn_readfirstlane(tid >> 6);
    const int G = gridDim.x, bx = blockIdx.x, vcu = (G % 8 == 0) ? (bx % 8) * (G / 8) + bx / 8 : bx;
    unsigned char* ws = a.ws;
    float* rowss = (float*)(ws + WS_ROWSS);
    bf16 *WIN_t = (bf16*)(ws + WS_WIN), *WAB_t = (bf16*)(ws + WS_WAB), *WO_t = (bf16*)(ws + WS_WO), *WUP_t = (bf16*)(ws + WS_WUP), *WDN_t = (bf16*)(ws + WS_WDN);
    bf16 *WC_t = (bf16*)(ws + WS_WC);
    bf16 *KCN = (bf16*)(ws + WS_KCN), *VCT = (bf16*)(ws + WS_VCT), *VT = (bf16*)(ws + WS_VT);
    bf16 *GN = (bf16*)(ws + WS_GN), *XN = (bf16*)(ws + WS_XN), *QB = (bf16*)(ws + WS_Q), *KVB = (bf16*)(ws + WS_KV), *UB = (bf16*)(ws + WS_U), *CB = (bf16*)(ws + WS_CB);
    bf16 *GA = (bf16*)a.out, *GB = (bf16*)a.out + (size_t)M * 1024, *ZO = (bf16*)(ws + WS_ZO), *MIX = (bf16*)(ws + WS_MIX), *HB = (bf16*)(ws + WS_H);
    const int gw = vcu * NWAVES + wave, NGW = G * NWAVES;
    unsigned* barw = (unsigned*)(ws + WS_BAR);
    for (int u = tid; u < (LDS_BYTES - RING_BYTES) / 4; u += NWAVES * 64) ((LAS unsigned*)(lds + RING_BYTES))[u] = 0u;
    __syncthreads();
    const XcdBarrier xbar = xcd_barrier_post(barw, (volatile LAS unsigned*)(lds + MISC_OFF) + 8);
    if (a.never) grid.sync();

    {
        LAS float* scr = (LAS float*)(lds + wave * 16384);
        constexpr int I_IN = 16 * 201, I_A = 8 * 32, I_B = 16 * 32, I_O = 16 * 32, I_UP = 16 * 128, I_DN = 64 * 32, I_C = 32 * 2;
        constexpr int I_PAD = NPAD - NPROJ, I_Z = M / 4096;
        constexpr int NITEMS = I_IN + I_A + I_B + I_O + I_UP + I_DN + 2 * I_C + I_PAD + I_Z;
        for (int it = gw; it < NITEMS; it += NGW) {
            int r = it;
            if (r < I_IN) { tr_item<true>(a.w_in, 1024, NPROJ, WIN_t, 1024, nullptr, scr, r, lane); continue; } r -= I_IN;
            if (r < I_A) { tr_item<false>(a.w_branch_a, 512, 1024, WAB_t, 1536, nullptr, scr, r, lane); continue; } r -= I_A;
            if (r < I_B) { tr_item<false>(a.w_branch_b, 1024, 1024, WAB_t + 512, 1536, nullptr, scr, r, lane); continue; } r -= I_B;
            if (r < I_O) { tr_item<false>(a.w_out, 1024, 1024, WO_t, 1024, nullptr, scr, r, lane); continue; } r -= I_O;
            if (r < I_UP) { tr_item<false>(a.w_up, 1024, 4096, WUP_t, 1024, a.norm2_g, scr, r, lane); continue; } r -= I_UP;
            if (r < I_DN) { tr_item<false>(a.w_down, 4096, 1024, WDN_t, 4096, nullptr, scr, r, lane); continue; } r -= I_DN;
            if (r < I_C) { tr_item<false>(a.w_cmp_k, 2048, 64, WC_t, 2048, nullptr, scr, r, lane); continue; } r -= I_C;
            if (r < I_C) { tr_item<false>(a.w_cmp_v, 2048, 64, WC_t + 64 * 2048, 2048, nullptr, scr, r, lane); continue; } r -= I_C;
            if (r < I_PAD) { v4u z = (v4u){0u, 0u, 0u, 0u}; v4u* p = (v4u*)(WIN_t + (size_t)(NPROJ + r) * 1024) + lane * 2; p[0] = z; p[1] = z; continue; } r -= I_PAD;
            { f32x4 z = (f32x4){0.f, 0.f, 0.f, 0.f}; f32x4* p = (f32x4*)(rowss + (size_t)r * 4096) + lane;
#pragma unroll
              for (int i = 0; i < 16; ++i) p[64 * i] = z; }
        }
        for (int m = gw; m < M; m += 4 * NGW) {
            const f32x4* gr = (const f32x4*)a.norm1_g + lane;
            f32x4 v[4][4];
#pragma unroll
            for (int q = 0; q < 4; ++q) { const int mm = (m + q * NGW < M) ? m + q * NGW : m; const f32x4* xr = (const f32x4*)(a.x + (size_t)mm * DM) + lane;
#pragma unroll
                for (int j = 0; j < 4; ++j) v[q][j] = __builtin_nontemporal_load(xr + 64 * j); }
#pragma unroll
            for (int q = 0; q < 4; ++q) {
                float sq = 0.f;
#pragma unroll
                for (int j = 0; j < 4; ++j) sq += (v[q][j].x * v[q][j].x + v[q][j].y * v[q][j].y) + (v[q][j].z * v[q][j].z + v[q][j].w * v[q][j].w);
                const float rstd = __builtin_amdgcn_rsqf(wave_sum(sq) * (1.f / DM) + EPS);
                if (m + q * NGW < M) {
                    v2u* o8 = (v2u*)(XN + (size_t)(m + q * NGW) * DM) + lane;
#pragma unroll
                    for (int j = 0; j < 4; ++j) { const f32x4 gg = gr[64 * j]; v2u wv; wv.x = pk2(v[q][j].x * rstd * gg.x, v[q][j].y * rstd * gg.y); wv.y = pk2(v[q][j].z * rstd * gg.z, v[q][j].w * rstd * gg.w); o8[64 * j] = wv; }
                }
            }
        }
    }
    xcd_barrier(xbar);

    {
        pg8::Gemm g{XN, WIN_t, M, NPAD, 1024}; pg8::StaticOrder S; S.init(M, NPAD, G, bx);
        pg8::EpiProj E{QB, KVB, UB, CB, GA, GB, GN, VT};
        pg8::gemm_phase<pg8::EpiProj, pg8::StaticOrder, true, true>(lds, g, S, E);
    }
    xcd_barrier(xbar);

    {
        const int r32 = lane & 31, hi = lane >> 5;
        const int e0 = (lane & 7) * 8;
        float kgv[8];
#pragma unroll
        for (int e = 0; e < 8; ++e) kgv[e] = a.k_norm_g[64 * (1 + ((lane >> 4) & 1)) + e0 + e];
        for (int rb = gw; rb < M / 16; rb += NGW) {
            const int m0 = rb * 16, tt0 = m0 & (SEQ - 1), bb = m0 / SEQ;
            const int kcol = (((lane >> 4) & 1) ? 512 : 256) + (lane & 15) * 8;
#pragma unroll 1
            for (int k4 = 0; k4 < 16; k4 += 4) {
                v4u kw[4];
#pragma unroll
                for (int i = 0; i < 4; ++i) { kw[i] = (v4u){0u, 0u, 0u, 0u}; if (lane < 32) kw[i] = *(const v4u*)(KVB + (size_t)(m0 + k4 + i) * 768 + kcol); }
#pragma unroll
                for (int i = 0; i < 4; ++i) {
                    const v4u w = kw[i];
                    float f[8] = {blo(w.x), bhi(w.x), blo(w.y), bhi(w.y), blo(w.z), bhi(w.z), blo(w.w), bhi(w.w)};
                    float ss = 0.f;
#pragma unroll
                    for (int e = 0; e < 8; ++e) ss += f[e] * f[e];
                    ss += __shfl_xor(ss, 1); ss += __shfl_xor(ss, 2); ss += __shfl_xor(ss, 4);
                    const float rstd = __builtin_amdgcn_rsqf(ss * (1.f / 64.f) + EPS);
                    v4u o; o.x = pk2(f[0] * rstd * kgv[0], f[1] * rstd * kgv[1]); o.y = pk2(f[2] * rstd * kgv[2], f[3] * rstd * kgv[3]); o.z = pk2(f[4] * rstd * kgv[4], f[5] * rstd * kgv[5]); o.w = pk2(f[6] * rstd * kgv[6], f[7] * rstd * kgv[7]);
                    if (lane < 32) *(v4u*)(KVB + (size_t)(m0 + k4 + i) * 768 + kcol) = o;
                }
            }
#pragma unroll 1
            for (int h = 0; h < 2; ++h) {
                const int ch = (h * 64 + lane) * 8;
                const f32x4 wa0 = *(const f32x4*)(a.conv_w + ch), wa1 = *(const f32x4*)(a.conv_w + ch + 4);
                const f32x4 wb0 = *(const f32x4*)(a.conv_w + 1024 + ch), wb1 = *(const f32x4*)(a.conv_w + 1024 + ch + 4);
                const f32x4 wc0 = *(const f32x4*)(a.conv_w + 2048 + ch), wc1 = *(const f32x4*)(a.conv_w + 2048 + ch + 4);
                v4u u1 = (v4u){0u, 0u, 0u, 0u}, u2 = (v4u){0u, 0u, 0u, 0u};
                if (tt0 != 0) { u1 = *(const v4u*)(UB + (size_t)(m0 - 1) * 1024 + ch); u2 = *(const v4u*)(UB + (size_t)(m0 - 2) * 1024 + ch); }
#pragma unroll 1
                for (int k4 = 0; k4 < 16; k4 += 4) {
                    v4u uu[4], cbv[4];
#pragma unroll
                    for (int i = 0; i < 4; ++i) { uu[i] = *(const v4u*)(UB + (size_t)(m0 + k4 + i) * 1024 + ch); cbv[i] = *(const v4u*)(CB + (size_t)(m0 + k4 + i) * 1024 + ch); }
#pragma unroll
                    for (int i = 0; i < 4; ++i) {
                        const v4u u0 = uu[i], cb = cbv[i]; v4u o;
                        o.x = pk2(blo(cb.x) * (wa0[0] * blo(u2.x) + wb0[0] * blo(u1.x) + wc0[0] * blo(u0.x)), bhi(cb.x) * (wa0[1] * bhi(u2.x) + wb0[1] * bhi(u1.x) + wc0[1] * bhi(u0.x)));
                        o.y = pk2(blo(cb.y) * (wa0[2] * blo(u2.y) + wb0[2] * blo(u1.y) + wc0[2] * blo(u0.y)), bhi(cb.y) * (wa0[3] * bhi(u2.y) + wb0[3] * bhi(u1.y) + wc0[3] * bhi(u0.y)));
                        o.z = pk2(blo(cb.z) * (wa1[0] * blo(u2.z) + wb1[0] * blo(u1.z) + wc1[0] * blo(u0.z)), bhi(cb.z) * (wa1[1] * bhi(u2.z) + wb1[1] * bhi(u1.z) + wc1[1] * bhi(u0.z)));
                        o.w = pk2(blo(cb.w) * (wa1[2] * blo(u2.w) + wb1[2] * blo(u1.w) + wc1[2] * blo(u0.w)), bhi(cb.w) * (wa1[3] * bhi(u2.w) + wb1[3] * bhi(u1.w) + wc1[3] * bhi(u0.w)));
                        *(v4u*)(ZO + (size_t)(m0 + k4 + i) * 1536 + 512 + ch) = o;
                        u2 = u1; u1 = u0;
                    }
                }
            }
        }
        for (int task = vcu; task < 256; task += G) {
            const int mat = task >> 7, rt = task & 127;
            const int R = rt * 32 + r32, bb = R >> 9, cc = (R >> 1) & 255, gg = R & 1;
            const bf16* abase = KVB + (size_t)(bb * SEQ + 16 * cc) * 768 + mat * 128 + gg * 64 + 8 * hi;
            const float* pos = (mat ? a.cmp_pos_v : a.cmp_pos_k) + 8 * hi;
            const bf16* wb = WC_t + (size_t)mat * (64 * 2048) + (size_t)r32 * 2048 + 8 * hi;
            f32x16 acc0 = f32x16{}, acc1 = f32x16{};
#pragma unroll
            for (int i = 0; i < 16; ++i) {
                const int kk = wave * 16 + i, l = kk >> 2, dd = (kk & 3) * 16;
                const v4u av = *(const v4u*)(abase + (size_t)l * 768 + dd);
                const f32x4 q0 = *(const f32x4*)(pos + l * 64 + dd), q1 = *(const f32x4*)(pos + l * 64 + dd + 4);
                const bf16x8 ap = pack8(blo(av.x) + q0[0], bhi(av.x) + q0[1], blo(av.y) + q0[2], bhi(av.y) + q0[3], blo(av.z) + q1[0], bhi(av.z) + q1[1], blo(av.w) + q1[2], bhi(av.w) + q1[3]);
                const bf16x8 b0 = *(const bf16x8*)(wb + 16 * kk), b1 = *(const bf16x8*)(wb + 32 * 2048 + 16 * kk);
                acc0 = MFMA32(ap, b0, acc0); acc1 = MFMA32(ap, b1, acc1);
            }
            LAS float* red = (LAS float*)lds + wave * 2048;
#pragma unroll
            for (int r = 0; r < 16; ++r) { red[crow(r, hi) * 64 + r32] = acc0[r]; red[crow(r, hi) * 64 + 32 + r32] = acc1[r]; }
            __syncthreads();
            {
                const int row = tid >> 4, c4 = (tid & 15) * 4;
                f32x4 sm = (f32x4){0.f, 0.f, 0.f, 0.f};
#pragma unroll
                for (int w8 = 0; w8 < 8; ++w8) sm += *(const LAS f32x4*)((LAS float*)lds + w8 * 2048 + row * 64 + c4);
                const int R2 = rt * 32 + row, b2 = R2 >> 9, c2 = (R2 >> 1) & 255, g2 = R2 & 1;
                if (c2 == 255) sm = (f32x4){0.f, 0.f, 0.f, 0.f};
                if (mat == 0) {
                    float ss = (sm[0] * sm[0] + sm[1] * sm[1]) + (sm[2] * sm[2] + sm[3] * sm[3]);
                    ss += __shfl_xor(ss, 1); ss += __shfl_xor(ss, 2); ss += __shfl_xor(ss, 4); ss += __shfl_xor(ss, 8);
                    const float rstd = __builtin_amdgcn_rsqf(ss * (1.f / 64.f) + EPS);
                    const f32x4 kg = *(const f32x4*)(a.k_norm_g + c4);
                    v2u o; o.x = pk2(sm[0] * rstd * kg[0], sm[1] * rstd * kg[1]); o.y = pk2(sm[2] * rstd * kg[2], sm[3] * rstd * kg[3]);
                    *(v2u*)(KCN + ((size_t)((b2 * 2 + g2) * 256 + c2)) * 64 + c4) = o;
                } else {
                    bf16* vo = VCT + ((size_t)(b2 * 2 + g2) * 64 + c4) * 256 + c2;
                    const unsigned w0 = pk2(sm[0], sm[1]), w1 = pk2(sm[2], sm[3]);
                    vo[0] = (bf16)(w0 & 0xffffu); vo[256] = (bf16)(w0 >> 16); vo[512] = (bf16)(w1 & 0xffffu); vo[768] = (bf16)(w1 >> 16);
                }
            }
            __syncthreads();
        }
    }
    xcd_barrier(xbar);

    {
        const AttnPtrs A{QB, KVB, GN, KCN, VCT, VT, ZO, a.q_norm_g};
        volatile LAS int* qslot = (volatile LAS int*)(lds + MISC_OFF) + 16;
        unsigned* queue = barw + XCD_BAR_WORDS + 64;
        int idx = bx;
        while (idx < 1024) {
            int nxt = 0;
            if (tid == 0) nxt = (int)atomicAdd(queue, 1u) + G;
            int b_, g_, cur_;
            if (idx < 368) { g_ = 1; cur_ = 63 - (idx >> 3); b_ = idx & 7; }
            else if (idx < 752) { const int r2 = idx - 368; if (r2 < 376) { g_ = 0; cur_ = 63 - (r2 >> 3); b_ = r2 & 7; } else { g_ = 1; cur_ = 17; b_ = r2 - 376; } }
            else { const int r3 = idx - 752; cur_ = 16 - (r3 >> 4); g_ = (r3 >> 3) & 1; b_ = r3 & 7; }
            attn_unit(A, lds, b_, g_, cur_);
            if (tid == 0) qslot[0] = nxt;
            __syncthreads();
            idx = qslot[0];
            __syncthreads();
        }
    }
    xcd_barrier(xbar);

    {
        pg8::Gemm g{ZO, WAB_t, M, 1024, 1536}; pg8::StaticOrder S; S.init(M, 1024, G, bx);
        pg8::EpiMix E{GA, GB, MIX, 1024};
        pg8::gemm_phase<pg8::EpiMix, pg8::StaticOrder, true, true>(lds, g, S, E);
    }
    xcd_barrier(xbar);
    {
        pg8::Gemm g{MIX, WO_t, M, 1024, 1024}; pg8::StaticOrder S; S.init(M, 1024, G, bx);
        pg8::EpiX1 E{a.x, XN, rowss};
        pg8::gemm_phase<pg8::EpiX1, pg8::StaticOrder, true, true>(lds, g, S, E);
    }
    xcd_barrier(xbar);
    {
        pg8::Gemm g{XN, WUP_t, M, DFF, 1024}; pg8::StaticOrder S; S.init(M, DFF, G, bx);
        pg8::EpiUp E{rowss, HB, DFF, {}};
        pg8::gemm_phase<pg8::EpiUp, pg8::StaticOrder, true, true>(lds, g, S, E);
    }
    xcd_barrier(xbar);
    {
        pg8::Gemm g{HB, WDN_t, M, 1024, DFF}; pg8::StaticOrder S; S.init(M, 1024, G, bx);
        pg8::EpiDown E{XN, a.out};
        pg8::gemm_phase<pg8::EpiDown, pg8::StaticOrder, true, true>(lds, g, S, E);
    }
}

extern "C" void kernel_launch(void* const* d_in, const int* in_sizes, int n_in, void* d_out, int out_size, void* d_ws, size_t ws_size, hipStream_t stream) {
    static int grid = 0;
    if (grid == 0) {
        if (n_in != 16 || out_size != M * DM || ws_size < WS_END) { fprintf(stderr, "kernel_launch: unexpected shapes (n_in %d, out %d, ws %zu)\n", n_in, out_size, ws_size); grid = -1; return; }
        int dev = 0, cus = 0, per_cu = 0;
        (void)hipGetDevice(&dev); (void)hipDeviceGetAttribute(&cus, hipDeviceAttributeMultiprocessorCount, dev);
        if (hipFuncSetAttribute((const void*)nsa_block_fwd, hipFuncAttributeMaxDynamicSharedMemorySize, LDS_BYTES) != hipSuccess) { fprintf(stderr, "kernel_launch: hipFuncSetAttribute failed\n"); grid = -1; return; }
        if (hipOccupancyMaxActiveBlocksPerMultiprocessor(&per_cu, (const void*)nsa_block_fwd, NWAVES * 64, LDS_BYTES) != hipSuccess || per_cu < 1) { fprintf(stderr, "kernel_launch: occupancy query says %d\n", per_cu); per_cu = 1; }
        (void)hipGetLastError();
        grid = cus * 1;
    }
    if (grid < 0) return;
    if (hipMemsetAsync((char*)d_ws + WS_BAR, 0, (XCD_BAR_WORDS + 128) * sizeof(unsigned), stream) != hipSuccess) { fprintf(stderr, "kernel_launch: hipMemsetAsync failed\n"); return; }
    Args a{};
    a.x = (const float*)d_in[0]; a.norm1_g = (const float*)d_in[1]; a.w_in = (const float*)d_in[2]; a.q_norm_g = (const float*)d_in[3]; a.k_norm_g = (const float*)d_in[4];
    a.cmp_pos_k = (const float*)d_in[5]; a.cmp_pos_v = (const float*)d_in[6]; a.w_cmp_k = (const float*)d_in[7]; a.w_cmp_v = (const float*)d_in[8]; a.conv_w = (const float*)d_in[9];
    a.w_branch_a = (const float*)d_in[10]; a.w_branch_b = (const float*)d_in[11]; a.w_out = (const float*)d_in[12]; a.norm2_g = (const float*)d_in[13]; a.w_up = (const float*)d_in[14]; a.w_down = (const float*)d_in[15];
    a.out = (float*)d_out; a.ws = (unsigned char*)d_ws;
    void* args[] = {&a};
    hipError_t e = hipLaunchCooperativeKernel((const void*)nsa_block_fwd, dim3(grid), dim3(NWAVES * 64), args, LDS_BYTES, stream);
    if (e != hipSuccess) fprintf(stderr, "kernel_launch: cooperative launch failed: %s (grid %d)\n", hipGetErrorString(e), grid);
}
```

```cpp
#include <hip/hip_runtime.h>
#include <hip/hip_cooperative_groups.h>
#include <cstdio>
#include <cstdint>
namespace cg = cooperative_groups;
namespace pg8 {
#define PG8_LAS __attribute__((address_space(3)))
typedef unsigned short bf16_t;
typedef short bf16x8 __attribute__((ext_vector_type(8)));
typedef float f32x4 __attribute__((ext_vector_type(4)));
typedef unsigned u32x4 __attribute__((ext_vector_type(4)));
constexpr int BM = 256, BK = 64, HALF = 128, HTB = HALF * BK * 2  , STAGE_BYTES = 8 * HTB, NXCD = 8, WGM = 8;

__host__ __device__ __forceinline__ int lds_byte(int r, int c) { const int st = (r >> 4) * 2 + (c >> 5), rr = r & 15, cc = c & 31, ob = rr * 64 + cc * 2; return st * 1024 + (ob ^ (((ob >> 9) & 1) << 5)); }
__host__ __device__ __forceinline__ void stage_rc(int b, int& R, int& C) { const int st = b / 1024, sb = b % 1024, swz = sb ^ (((sb >> 9) & 1) << 5); R = (st >> 1) * 16 + swz / 64; C = (st & 1) * 32 + (swz % 64) / 2; }
__host__ __device__ __forceinline__ int perm32(int rho) { const int n = rho >> 4, i = rho & 15; return 8 * (i >> 2) + 4 * n + (i & 3); }

struct Unit { int pm, pn; };
struct Gemm { const bf16_t* A; const bf16_t* Bt; int M, N, K; };

struct StaticOrder {
    int nM, nN, nwg, G, c;
    __host__ __device__ void init(int M, int N, int G_, int c_) { nM = M / BM; nN = N / BM; nwg = nM * nN; G = G_; c = c_; }
    __host__ __device__ bool next(int i, Unit& u) const {
        const long L = (long)i * G + c; if (L >= nwg) return false;
        int wgid = (int)L; { const int q = nwg / NXCD, r = nwg % NXCD, xcd = wgid % NXCD, off = wgid / NXCD; wgid = (xcd < r ? xcd * (q + 1) : r * (q + 1) + (xcd - r) * q) + off; }
        const int nig = WGM * nN, gid = wgid / nig, fm = gid * WGM, gsz = (nM - fm) < WGM ? (nM - fm) : WGM;
        u.pm = fm + ((wgid % nig) % gsz); u.pn = (wgid % nig) / gsz; return true;
    }
    __device__ __forceinline__ void a_ready(const Unit&) const {}
    __device__ __forceinline__ void done(const Unit&) const {}
};

typedef float pg8_f32x2_t __attribute__((ext_vector_type(2))); typedef __bf16 pg8_bf16x2_t __attribute__((ext_vector_type(2)));
__device__ __forceinline__ unsigned cvt_pk_bf16(float lo, float hi) { pg8_f32x2_t v = {lo, hi}; pg8_bf16x2_t b = __builtin_convertvector(v, pg8_bf16x2_t); return __builtin_bit_cast(unsigned, b); }
typedef float f32x2 __attribute__((ext_vector_type(2)));
typedef unsigned u32x2 __attribute__((ext_vector_type(2)));
__device__ __forceinline__ float bflo(unsigned w) { return __uint_as_float(w << 16); }
__device__ __forceinline__ float bfhi(unsigned w) { return __uint_as_float(w & 0xffff0000u); }
__device__ __forceinline__ float sigm(float x) { return __builtin_amdgcn_rcpf(1.f + __expf(-x)); }

struct EpiProj {
    static constexpr bool PERM = true, AFTER_DRAIN = false; static constexpr int MID_T = 0; static constexpr bool HAS_PRE = false;
    bf16_t *Q, *KV, *U, *CB, *GA, *GB, *GN, *VT;
    static __device__ __forceinline__ u32x4 pack(const f32x4& v0, const f32x4& v1) { u32x4 w; w.x = cvt_pk_bf16(v0[0], v0[1]); w.y = cvt_pk_bf16(v0[2], v0[3]); w.z = cvt_pk_bf16(v1[0], v1[1]); w.w = cvt_pk_bf16(v1[2], v1[3]); return w; }
    __device__ __forceinline__ void plain(const f32x4 (&acc)[2][2][4][2], bf16_t* base, int ldc, int row0, int col0) const {
#pragma unroll
        for (int ai = 0; ai < 2; ++ai)
#pragma unroll
            for (int m = 0; m < 4; ++m) {
                bf16_t* rowp = base + (size_t)(row0 + ai * HALF + m * 16) * ldc + col0;
#pragma unroll
                for (int bj = 0; bj < 2; ++bj) *(u32x4*)(rowp + bj * HALF) = pack(acc[ai][bj][m][0], acc[ai][bj][m][1]);
            }
    }
    __device__ __forceinline__ void operator()(const f32x4 (&acc)[2][2][4][2], const Unit& u, int wr, int wc, int fr, int fq) const {
        const int pn = u.pn, row0 = u.pm * BM + wr * 64 + fr, cw = wc * 32 + 8 * fq;
        if (pn < 2) {
#pragma unroll
            for (int ai = 0; ai < 2; ++ai)
#pragma unroll
                for (int m = 0; m < 4; ++m)
#pragma unroll
                    for (int bj = 0; bj < 2; ++bj) __builtin_nontemporal_store(pack(acc[ai][bj][m][0], acc[ai][bj][m][1]), (u32x4*)(Q + (size_t)(row0 + ai * HALF + m * 16) * 512 + pn * 256 + cw + bj * HALF));
        }
        else if (pn == 2) plain(acc, KV, 768, row0, cw);
        else if (pn < 5) {
#pragma unroll
            for (int ai = 0; ai < 2; ++ai)
#pragma unroll
                for (int m = 0; m < 4; ++m) {
                    const int row = row0 + ai * HALF + m * 16;
                    *(u32x4*)(KV + (size_t)row * 768 + (pn - 2) * 256 + cw) = pack(acc[ai][0][m][0], acc[ai][0][m][1]);
                    const u32x4 w = pack(acc[ai][1][m][0], acc[ai][1][m][1]);
                    bf16_t* vt = VT + ((size_t)((((row >> 12) * 2 + (pn - 3)) * 2 + (wc >> 1)) * 64 + (wc & 1) * 32 + 8 * fq)) * 4096 + (row & 4095);
                    vt[0 * 4096] = (bf16_t)(w.x & 0xffffu); vt[1 * 4096] = (bf16_t)(w.x >> 16); vt[2 * 4096] = (bf16_t)(w.y & 0xffffu); vt[3 * 4096] = (bf16_t)(w.y >> 16);
                    vt[4 * 4096] = (bf16_t)(w.z & 0xffffu); vt[5 * 4096] = (bf16_t)(w.z >> 16); vt[6 * 4096] = (bf16_t)(w.w & 0xffffu); vt[7 * 4096] = (bf16_t)(w.w >> 16);
                }
        } else if (pn < 13) {
#pragma unroll
            for (int ai = 0; ai < 2; ++ai)
#pragma unroll
                for (int m = 0; m < 4; ++m)
                    *(u32x4*)(U + (size_t)(row0 + ai * HALF + m * 16) * 1024 + (pn - 5) * 128 + cw) = pack(acc[ai][0][m][0] * acc[ai][1][m][0], acc[ai][0][m][1] * acc[ai][1][m][1]);
        } else if (pn < 17) plain(acc, CB, 1024, row0, (pn - 13) * 256 + cw);
        else if (pn < 25) {
#pragma unroll
            for (int ai = 0; ai < 2; ++ai)
#pragma unroll
                for (int m = 0; m < 4; ++m) {
                    f32x4 a0 = acc[ai][0][m][0], a1 = acc[ai][0][m][1], b0 = acc[ai][1][m][0], b1 = acc[ai][1][m][1];
#pragma unroll
                    for (int i = 0; i < 4; ++i) {
                        const float eb0 = 1.f + __expf(-b0[i]), eb1 = 1.f + __expf(-b1[i]), ea0 = 1.f + __expf(-a0[i]), ea1 = 1.f + __expf(-a1[i]);
                        b0[i] = __builtin_amdgcn_rcpf(eb0); b1[i] = __builtin_amdgcn_rcpf(eb1); a0[i] = eb0 * __builtin_amdgcn_rcpf(ea0); a1[i] = eb1 * __builtin_amdgcn_rcpf(ea1); }
                    const size_t off = (size_t)(row0 + ai * HALF + m * 16) * 1024 + (pn - 17) * 128 + cw;
                    __builtin_nontemporal_store(pack(a0, a1), (u32x4*)(GA + off)); __builtin_nontemporal_store(pack(b0, b1), (u32x4*)(GB + off));
                }
        } else if (wc == 0) {
#pragma unroll
            for (int ai = 0; ai < 2; ++ai)
#pragma unroll
                for (int m = 0; m < 4; ++m) {
                    f32x4 v0 = acc[ai][0][m][0], v1 = acc[ai][0][m][1];
#pragma unroll
                    for (int i = 0; i < 4; ++i) { v0[i] = sigm(v0[i]); v1[i] = sigm(v1[i]); }
                    *(u32x4*)(GN + (size_t)(row0 + ai * HALF + m * 16) * 32 + 8 * fq) = pack(v0, v1);
                }
        }
    }
};
struct EpiMix {
    static constexpr bool PERM = true, AFTER_DRAIN = false; static constexpr int MID_T = 8; static constexpr bool HAS_PRE = false;
    const bf16_t* GA; const bf16_t* GB; bf16_t* O; int ldc;
    __device__ __forceinline__ void mid(f32x4 (&acc)[2][2][4][2], const Unit& u, int wr, int wc, int fr, int fq) const {
        int row0 = u.pm * BM + wr * 64 + fr, col0 = u.pn * BM + wc * 32 + 8 * fq;
        asm volatile("" : "+v"(row0), "+v"(col0));
#pragma unroll
        for (int ai = 0; ai < 2; ++ai)
#pragma unroll
            for (int m = 0; m < 4; ++m)
#pragma unroll
                for (int bj = 0; bj < 2; ++bj) {
                    const size_t off = (size_t)(row0 + ai * HALF + m * 16) * ldc + col0 + bj * HALF;
                    const u32x4 a = *(const u32x4*)(GA + off);
                    acc[ai][bj][m][0] *= (f32x4){bflo(a.x), bfhi(a.x), bflo(a.y), bfhi(a.y)}; acc[ai][bj][m][1] *= (f32x4){bflo(a.z), bfhi(a.z), bflo(a.w), bfhi(a.w)};
                }
    }
    __device__ __forceinline__ void operator()(const f32x4 (&acc)[2][2][4][2], const Unit& u, int wr, int wc, int fr, int fq) const {
        const int row0 = u.pm * BM + wr * 64 + fr, col0 = u.pn * BM + wc * 32 + 8 * fq;
        u32x4 g[2][4][2];
#pragma unroll
        for (int ai = 0; ai < 2; ++ai)
#pragma unroll
            for (int m = 0; m < 4; ++m)
#pragma unroll
                for (int bj = 0; bj < 2; ++bj) g[ai][m][bj] = *(const u32x4*)(GB + (size_t)(row0 + ai * HALF + m * 16) * ldc + col0 + bj * HALF);
#pragma unroll
        for (int ai = 0; ai < 2; ++ai)
#pragma unroll
            for (int m = 0; m < 4; ++m)
#pragma unroll
                for (int bj = 0; bj < 2; ++bj) {
                    const size_t off = (size_t)(row0 + ai * HALF + m * 16) * ldc + col0 + bj * HALF;
                    const u32x4 gg = g[ai][m][bj];
                    const f32x4 v0 = acc[ai][bj][m][0], v1 = acc[ai][bj][m][1];
                    u32x4 w;
                    w.x = cvt_pk_bf16(bflo(gg.x) * v0[0], bfhi(gg.x) * v0[1]);
                    w.y = cvt_pk_bf16(bflo(gg.y) * v0[2], bfhi(gg.y) * v0[3]);
                    w.z = cvt_pk_bf16(bflo(gg.z) * v1[0], bfhi(gg.z) * v1[1]);
                    w.w = cvt_pk_bf16(bflo(gg.w) * v1[2], bfhi(gg.w) * v1[3]);
                    *(u32x4*)(O + off) = w;
                }
    }
};
struct EpiX1 {
    static constexpr bool PERM = false, AFTER_DRAIN = false; static constexpr int MID_T = 0; static constexpr bool HAS_PRE = false;
    const float* x; bf16_t* xb; float* rowss;
    __device__ __forceinline__ void operator()(const f32x4 (&acc)[2][2][4][2], const Unit& u, int wr, int wc, int fr, int fq) const {
        const int row0 = u.pm * BM + wr * 64 + fr, col0 = u.pn * BM + wc * 32 + 4 * fq;
        f32x4 xa[2][2][2], xb_[2][2][2];
#define X1_LOAD(dst, g) do { _Pragma("unroll") for (int mm = 0; mm < 2; ++mm) _Pragma("unroll") for (int bj = 0; bj < 2; ++bj) _Pragma("unroll") for (int n = 0; n < 2; ++n) \
            dst[mm][bj][n] = *(const f32x4*)(x + (size_t)(row0 + ((g) >> 1) * HALF + (2 * ((g) & 1) + mm) * 16) * 1024 + col0 + bj * HALF + n * 16); } while (0)
#define X1_STORE(src, g) do { _Pragma("unroll") for (int mm = 0; mm < 2; ++mm) { const int ai = (g) >> 1, m = 2 * ((g) & 1) + mm, row = row0 + ai * HALF + m * 16; float ss = 0.f; \
            _Pragma("unroll") for (int bj = 0; bj < 2; ++bj) _Pragma("unroll") for (int n = 0; n < 2; ++n) { const size_t off = (size_t)row * 1024 + col0 + bj * HALF + n * 16; \
                const f32x4 vv = src[mm][bj][n] + acc[ai][bj][m][n]; ss += (vv[0] * vv[0] + vv[1] * vv[1]) + (vv[2] * vv[2] + vv[3] * vv[3]); \
                u32x2 w; w.x = cvt_pk_bf16(vv[0], vv[1]); w.y = cvt_pk_bf16(vv[2], vv[3]); *(u32x2*)(xb + off) = w; } \
            ss += __shfl_xor(ss, 16); ss += __shfl_xor(ss, 32); if (fq == 0) atomicAdd(rowss + row, ss); } } while (0)
        X1_LOAD(xa, 0); X1_LOAD(xb_, 1);
        X1_STORE(xa, 0); X1_LOAD(xa, 2);
        X1_STORE(xb_, 1); X1_LOAD(xb_, 3);
        X1_STORE(xa, 2);
        X1_STORE(xb_, 3);
#undef X1_LOAD
#undef X1_STORE
    }
};
struct EpiUp {
    static constexpr bool PERM = true, AFTER_DRAIN = false; static constexpr int MID_T = 0; static constexpr bool HAS_PRE = true;
    const float* rowss; bf16_t* H; int ldc;
    mutable float rsv[2][4];
    __device__ __forceinline__ void pre(const Unit& u, int wr, int fr) const {
        const int row0 = u.pm * BM + wr * 64 + fr;
#pragma unroll
        for (int ai = 0; ai < 2; ++ai)
#pragma unroll
            for (int m = 0; m < 4; ++m) rsv[ai][m] = rowss[row0 + ai * HALF + m * 16];
    }
    __device__ __forceinline__ void operator()(const f32x4 (&acc)[2][2][4][2], const Unit& u, int wr, int wc, int fr, int fq) const {
        const int row0 = u.pm * BM + wr * 64 + fr, col0 = u.pn * BM + wc * 32 + 8 * fq;
#pragma unroll
        for (int ai = 0; ai < 2; ++ai)
#pragma unroll
            for (int m = 0; m < 4; ++m) {
                const int row = row0 + ai * HALF + m * 16;
                const float rs = __builtin_amdgcn_rsqf(rsv[ai][m] * (1.0f / 1024.0f) + 1e-6f);
#pragma unroll
                for (int bj = 0; bj < 2; ++bj) {
                    f32x4 v0 = acc[ai][bj][m][0] * rs, v1 = acc[ai][bj][m][1] * rs;
#pragma unroll
                    for (int i = 0; i < 4; ++i) { const float a = fmaxf(v0[i], 0.f), b = fmaxf(v1[i], 0.f); v0[i] = a * a; v1[i] = b * b; }
                    u32x4 w; w.x = cvt_pk_bf16(v0[0], v0[1]); w.y = cvt_pk_bf16(v0[2], v0[3]); w.z = cvt_pk_bf16(v1[0], v1[1]); w.w = cvt_pk_bf16(v1[2], v1[3]);
                    *(u32x4*)(H + (size_t)row * ldc + col0 + bj * HALF) = w;
                }
            }
    }
};
struct EpiDown {
    static constexpr bool PERM = false, AFTER_DRAIN = false; static constexpr int MID_T = 0; static constexpr bool HAS_PRE = false;
    const bf16_t* xb; float* out;
    __device__ __forceinline__ void operator()(const f32x4 (&acc)[2][2][4][2], const Unit& u, int wr, int wc, int fr, int fq) const {
        const int row0 = u.pm * BM + wr * 64 + fr, col0 = u.pn * BM + wc * 32 + 4 * fq;
        u32x2 xr[2][4][2][2];
#pragma unroll
        for (int ai = 0; ai < 2; ++ai)
#pragma unroll
            for (int m = 0; m < 4; ++m)
#pragma unroll
                for (int bj = 0; bj < 2; ++bj)
#pragma unroll
                    for (int n = 0; n < 2; ++n) xr[ai][m][bj][n] = *(const u32x2*)(xb + (size_t)(row0 + ai * HALF + m * 16) * 1024 + col0 + bj * HALF + n * 16);
#pragma unroll
        for (int ai = 0; ai < 2; ++ai)
#pragma unroll
            for (int m = 0; m < 4; ++m)
#pragma unroll
                for (int bj = 0; bj < 2; ++bj)
#pragma unroll
                    for (int n = 0; n < 2; ++n) { const u32x2 xw = xr[ai][m][bj][n];
                        *(f32x4*)(out + (size_t)(row0 + ai * HALF + m * 16) * 1024 + col0 + bj * HALF + n * 16) = (f32x4){bflo(xw.x), bfhi(xw.x), bflo(xw.y), bfhi(xw.y)} + acc[ai][bj][m][n]; }
    }
};
template <class Epi, class Sched, bool ALIGN_EPI = false, bool SP2 = false>
__device__ __forceinline__ void gemm_phase(PG8_LAS unsigned char* lds, const Gemm g, const Sched& S, const Epi& E) {
    int tid_ = threadIdx.x; asm volatile("" : "+v"(tid_));
    const int tid = tid_, wid = __builtin_amdgcn_readfirstlane(tid >> 6), lane = tid & 63, wr = wid >> 2, wc = wid & 3, fr = lane & 15, fq = lane >> 4;
    const int K = g.K, nt = K / BK;
    unsigned voffA[2], voffB[2];
#pragma unroll
    for (int i = 0; i < 2; ++i) { int R, C; stage_rc(tid * 16 + i * 8192, R, C); const int Rb = Epi::PERM ? ((R & ~31) + perm32(R & 31)) : R;
        voffA[i] = (unsigned)(R * K + C) * 2u; voffB[i] = (unsigned)(Rb * K + C) * 2u; }
    const size_t kstep = (size_t)(BK * 2);
    const size_t hstep = (size_t)HALF * K * 2;
    const size_t tstep = 2 * hstep;
    const unsigned ldsw = (unsigned)wid * 1024u;
    const int aoff = lds_byte(wr * 64 + fr, fq * 8), boff = lds_byte(wc * 32 + fr, fq * 8);
#define PG8_SA(b, h) (((b) * 2 + (h)) * HTB)
#define PG8_SB(b, h) ((4 + (b) * 2 + (h)) * HTB)
#define PG8_STAGE(bufoff, gbase, voff) do { _Pragma("unroll") for (int _i = 0; _i < 2; ++_i) \
        __builtin_amdgcn_global_load_lds((const unsigned*)((const char*)(gbase) + (voff)[_i]), (PG8_LAS unsigned*)(lds + (bufoff) + ldsw + _i * 8192), 16, 0, 0); } while (0)
#define PG8_LDA(dst, b, h) do { _Pragma("unroll") for (int m = 0; m < 4; ++m) _Pragma("unroll") for (int k = 0; k < 2; ++k) dst[m][k] = *(const PG8_LAS bf16x8*)(lds + PG8_SA(b, h) + aoff + m * 2048 + k * 1024); } while (0)
#define PG8_LDB(dst, b, h) do { _Pragma("unroll") for (int n = 0; n < 2; ++n) _Pragma("unroll") for (int k = 0; k < 2; ++k) dst[n][k] = *(const PG8_LAS bf16x8*)(lds + PG8_SB(b, h) + boff + n * 2048 + k * 1024); } while (0)
#define PG8_MMA(ai, bj, At, Bt) do { __builtin_amdgcn_s_setprio(1); _Pragma("unroll") for (int m = 0; m < 4; ++m) _Pragma("unroll") for (int n = 0; n < 2; ++n) _Pragma("unroll") for (int k = 0; k < 2; ++k) \
        acc[ai][bj][m][n] = __builtin_amdgcn_mfma_f32_16x16x32_bf16(Bt[n][k], At[m][k], acc[ai][bj][m][n], 0, 0, 0); __builtin_amdgcn_s_setprio(0); } while (0)
#define PG8_WAIT_V(n) asm volatile("s_waitcnt vmcnt(" #n ")" ::: "memory")
#define PG8_WAIT_L(n) asm volatile("s_waitcnt lgkmcnt(" #n ")" ::: "memory")
#define PG8_BAR __builtin_amdgcn_s_barrier()
#define PG8_SCHED __builtin_amdgcn_sched_barrier(0)
    Unit cur, nxt; int ui = 0;
    if (!S.next(0, cur)) return;
    f32x4 acc[2][2][4][2];
#pragma unroll
    for (int a = 0; a < 2; ++a)
#pragma unroll
        for (int b = 0; b < 2; ++b)
#pragma unroll
            for (int m = 0; m < 4; ++m)
#pragma unroll
                for (int n = 0; n < 2; ++n) acc[a][b][m][n] = (f32x4){0.f, 0.f, 0.f, 0.f};
    bf16x8 At[4][2], B0[2][2], B1[2][2];
    const char* cA = (const char*)g.A + (size_t)cur.pm * tstep; const char* cB = (const char*)g.Bt + (size_t)cur.pn * tstep;
    S.a_ready(cur);
    if constexpr (SP2) {
        PG8_STAGE(PG8_SB(0, 0), cB, voffB); PG8_STAGE(PG8_SB(0, 1), cB + hstep, voffB); PG8_STAGE(PG8_SA(0, 0), cA, voffA); PG8_STAGE(PG8_SA(0, 1), cA + hstep, voffA);
        if (wr == 1) PG8_BAR;
        PG8_WAIT_V(2); PG8_BAR;
        PG8_STAGE(PG8_SB(1, 0), cB + kstep, voffB); PG8_STAGE(PG8_SA(1, 0), cA + kstep, voffA); PG8_STAGE(PG8_SB(1, 1), cB + hstep + kstep, voffB);
        PG8_WAIT_V(6); PG8_BAR;
    } else {
        PG8_STAGE(PG8_SB(0, 0), cB, voffB); PG8_STAGE(PG8_SA(0, 0), cA, voffA); PG8_STAGE(PG8_SB(0, 1), cB + hstep, voffB); PG8_STAGE(PG8_SA(0, 1), cA + hstep, voffA);
        if (wr == 1) PG8_BAR;
        PG8_WAIT_V(4); PG8_BAR;
        PG8_STAGE(PG8_SB(1, 0), cB + kstep, voffB); PG8_STAGE(PG8_SA(1, 0), cA + kstep, voffA); PG8_STAGE(PG8_SB(1, 1), cB + hstep + kstep, voffB);
        PG8_WAIT_V(6); PG8_BAR;
    }
    for (;;) {
        const bool has_next = S.next(ui + 1, nxt);
        const char* nA = has_next ? (const char*)g.A + (size_t)nxt.pm * tstep : cA; const char* nB = has_next ? (const char*)g.Bt + (size_t)nxt.pn * tstep : cB;
        for (int t = 0; t < nt; t += 2) {
            if constexpr (Epi::MID_T > 0) { if (t == Epi::MID_T) E.mid(acc, cur, wr, wc, fr, fq); }
            const bool last = (t == nt - 2);
            const char* a1 = cA + (size_t)(t + 1) * kstep;
            const char* a2 = last ? nA : cA + (size_t)(t + 2) * kstep; const char* b2 = last ? nB : cB + (size_t)(t + 2) * kstep;
            const char* a3 = a2 + kstep; const char* b3 = b2 + kstep;
            if (last && has_next) S.a_ready(nxt);
            if constexpr (Epi::HAS_PRE) { if (last) E.pre(cur, wr, fr); }
            if constexpr (SP2) {
            PG8_LDB(B0, 0, 0); PG8_LDB(B1, 0, 1); PG8_SCHED; PG8_LDA(At, 0, 0); PG8_STAGE(PG8_SA(1, 1), a1 + hstep, voffA);
            PG8_WAIT_V(8); PG8_WAIT_L(0); PG8_BAR; PG8_MMA(0, 0, At, B0); PG8_MMA(0, 1, At, B1); PG8_BAR; PG8_SCHED;
            PG8_LDA(At, 0, 1); PG8_STAGE(PG8_SB(0, 0), b2, voffB); PG8_STAGE(PG8_SB(0, 1), b2 + hstep, voffB); PG8_STAGE(PG8_SA(0, 0), a2, voffA);
            PG8_WAIT_V(8); PG8_WAIT_L(0); PG8_BAR; PG8_MMA(1, 0, At, B0); PG8_MMA(1, 1, At, B1); PG8_BAR; PG8_SCHED;
            PG8_LDB(B0, 1, 0); PG8_LDB(B1, 1, 1); PG8_SCHED; PG8_LDA(At, 1, 0); PG8_STAGE(PG8_SA(0, 1), a2 + hstep, voffA);
            PG8_WAIT_V(8); PG8_WAIT_L(0); PG8_BAR; PG8_MMA(0, 0, At, B0); PG8_MMA(0, 1, At, B1); PG8_BAR; PG8_SCHED;
            PG8_LDA(At, 1, 1); PG8_STAGE(PG8_SB(1, 0), b3, voffB); PG8_STAGE(PG8_SB(1, 1), b3 + hstep, voffB); PG8_STAGE(PG8_SA(1, 0), a3, voffA);
            PG8_WAIT_V(8); PG8_WAIT_L(0); PG8_BAR; PG8_MMA(1, 0, At, B0); PG8_MMA(1, 1, At, B1); PG8_BAR; PG8_SCHED;
            } else {
            PG8_LDB(B0, 0, 0); PG8_SCHED; PG8_LDA(At, 0, 0); PG8_STAGE(PG8_SA(1, 1), a1 + hstep, voffA);
            PG8_WAIT_L(8); PG8_BAR; PG8_WAIT_L(0); PG8_MMA(0, 0, At, B0); PG8_BAR; PG8_SCHED;
            PG8_LDB(B1, 0, 1); PG8_STAGE(PG8_SB(0, 0), b2, voffB);
            PG8_BAR; PG8_WAIT_L(0); PG8_MMA(0, 1, At, B1); PG8_BAR;
            PG8_LDA(At, 0, 1); PG8_STAGE(PG8_SA(0, 0), a2, voffA);
            PG8_BAR; PG8_WAIT_L(0); PG8_MMA(1, 0, At, B0); PG8_BAR; PG8_SCHED;
            PG8_STAGE(PG8_SB(0, 1), b2 + hstep, voffB);
            PG8_WAIT_V(6); PG8_BAR; PG8_MMA(1, 1, At, B1); PG8_BAR;
            PG8_LDB(B0, 1, 0); PG8_SCHED; PG8_LDA(At, 1, 0); PG8_STAGE(PG8_SA(0, 1), a2 + hstep, voffA);
            PG8_WAIT_L(8); PG8_BAR; PG8_WAIT_L(0); PG8_MMA(0, 0, At, B0); PG8_BAR; PG8_SCHED;
            PG8_LDB(B1, 1, 1); PG8_STAGE(PG8_SB(1, 0), b3, voffB);
            PG8_BAR; PG8_WAIT_L(0); PG8_MMA(0, 1, At, B1); PG8_BAR;
            PG8_LDA(At, 1, 1); PG8_STAGE(PG8_SA(1, 0), a3, voffA);
            PG8_BAR; PG8_WAIT_L(0); PG8_MMA(1, 0, At, B0); PG8_BAR; PG8_SCHED;
            PG8_STAGE(PG8_SB(1, 1), b3 + hstep, voffB);
            PG8_WAIT_V(6); PG8_BAR; PG8_MMA(1, 1, At, B1); PG8_BAR;
            }
        }
        if constexpr (ALIGN_EPI) { if (wr == 0) PG8_BAR; }
        if constexpr (!Epi::AFTER_DRAIN) { E(acc, cur, wr, wc, fr, fq); S.done(cur); }
        if (!has_next) break;
#pragma unroll
        for (int a = 0; a < 2; ++a)
#pragma unroll
            for (int b = 0; b < 2; ++b)
#pragma unroll
                for (int m = 0; m < 4; ++m)
#pragma unroll
                    for (int n = 0; n < 2; ++n) acc[a][b][m][n] = (f32x4){0.f, 0.f, 0.f, 0.f};
        cur = nxt; cA = nA; cB = nB; ++ui;
        if constexpr (ALIGN_EPI) { if (wr == 1) PG8_BAR; }
    }
    PG8_WAIT_V(0);
    if constexpr (!ALIGN_EPI) { if (wr == 0) PG8_BAR; }
    PG8_BAR;
    if constexpr (Epi::AFTER_DRAIN) { E.fused(acc, cur, wr, wc, fr, fq, lds, wid, lane); S.done(cur); }
#undef PG8_SA
#undef PG8_SB
#undef PG8_STAGE
#undef PG8_LDA
#undef PG8_LDB
#undef PG8_MMA
#undef PG8_WAIT_V
#undef PG8_WAIT_L
#undef PG8_BAR
#undef PG8_SCHED
}
}

constexpr int BATCH = 8, SEQ = 4096, DM = 1024, M = BATCH * SEQ, NPROJ = 6424, NPAD = 6656, DFF = 4096;
constexpr float EPS = 1e-6f, LOG2E = 1.4426950408889634f;
constexpr int NWAVES = 8;
constexpr size_t MiB = 1u << 20;
constexpr size_t WS_ROWSS = 0;
constexpr size_t WS_WIN = 2 * MiB, WS_WAB = 15 * MiB  , WS_WO = 18 * MiB, WS_WUP = 20 * MiB, WS_WDN = 28 * MiB;
constexpr size_t WS_WC = 36 * MiB;
constexpr size_t WS_POSB = 36 * MiB + 512 * 1024;
constexpr size_t WS_KCN = 37 * MiB;
constexpr size_t WS_VCT = 38 * MiB;
constexpr size_t WS_VT = 480 * MiB;
constexpr size_t WS_GN = 43 * MiB;
constexpr size_t WS_XN = 48 * MiB;
constexpr size_t WS_Q = 112 * MiB;
constexpr size_t WS_KV = 144 * MiB;
constexpr size_t WS_U = 192 * MiB;
constexpr size_t WS_CB = 256 * MiB;
constexpr size_t WS_ZO = 320 * MiB;
constexpr size_t WS_MIX = 112 * MiB;
constexpr size_t WS_H = 192 * MiB;
constexpr size_t WS_END = 496 * MiB;
constexpr int RING_BYTES = 131072, LDS_BYTES = 147456, MISC_OFF = RING_BYTES + 320;
constexpr size_t WS_BAR = 1 * MiB;

#define LAS __attribute__((address_space(3)))
typedef unsigned short bf16;
typedef unsigned v4u __attribute__((ext_vector_type(4)));
typedef unsigned v2u __attribute__((ext_vector_type(2)));
typedef float f32x4 __attribute__((ext_vector_type(4)));
typedef float f32x16 __attribute__((ext_vector_type(16)));
typedef short bf16x8 __attribute__((ext_vector_type(8)));
typedef short s16x4 __attribute__((ext_vector_type(4)));
typedef float f32x2_t __attribute__((ext_vector_type(2)));
typedef __bf16 bf16x2_t __attribute__((ext_vector_type(2)));
#define LDS_WAIT() asm volatile("s_waitcnt lgkmcnt(0)" ::: "memory")
#define MFMA32(a, b, c) __builtin_amdgcn_mfma_f32_32x32x16_bf16(a, b, c, 0, 0, 0)
__device__ __forceinline__ unsigned pk2(float lo, float hi) { f32x2_t v = {lo, hi}; bf16x2_t b = __builtin_convertvector(v, bf16x2_t); return __builtin_bit_cast(unsigned, b); }
__device__ __forceinline__ float bf2f(bf16 h) { return __uint_as_float((unsigned)h << 16); }
__device__ __forceinline__ float blo(unsigned w) { return __uint_as_float(w << 16); }
__device__ __forceinline__ float bhi(unsigned w) { return __uint_as_float(w & 0xffff0000u); }
__device__ __forceinline__ bf16x8 pack8(float a0, float a1, float a2, float a3, float a4, float a5, float a6, float a7) {
    v4u w; w.x = pk2(a0, a1); w.y = pk2(a2, a3); w.z = pk2(a4, a5); w.w = pk2(a6, a7); return __builtin_bit_cast(bf16x8, w); }
__device__ __forceinline__ int crow(int r, int hi) { return (r & 3) + 8 * (r >> 2) + 4 * hi; }
__device__ __forceinline__ float ex2(float x) { return __builtin_amdgcn_exp2f(x); }

struct Args {
    const float *x, *norm1_g, *w_in, *q_norm_g, *k_norm_g, *cmp_pos_k, *cmp_pos_v, *w_cmp_k, *w_cmp_v, *conv_w, *w_branch_a, *w_branch_b, *w_out, *norm2_g, *w_up, *w_down;
    float* out; unsigned char* ws;
    int never; int pad;
};

#define XB_TMO      128
#define XB_XCNT(j)  (256  + 64 * (j))
#define XB_XSUB(j)  (1280 + 64 * (j))
#define XB_XGEN(j)  (2304 + 64 * (j))
#define XB_TOP      3328
#define XB_TOPGEN   3392
#define XCD_BAR_WORDS 3456
#define XB_SPIN_CAP (1u << 18)

__device__ __forceinline__ unsigned xb_ld(unsigned* p)              { return __hip_atomic_load(p, __ATOMIC_RELAXED, __HIP_MEMORY_SCOPE_AGENT); }
__device__ __forceinline__ unsigned xb_add(unsigned* p, unsigned v) { return __hip_atomic_fetch_add(p, v, __ATOMIC_RELAXED, __HIP_MEMORY_SCOPE_AGENT); }
__device__ __forceinline__ unsigned xb_xcc_id() { return (unsigned)__builtin_amdgcn_s_getreg((3 << 11) | 20) & 0xFu; }
#define XB_SPIN(cond, bar) do { unsigned _sp = 0; while (cond) { __builtin_amdgcn_s_sleep(1); \
    if ((++_sp & 255u) == 0u) { if (xb_ld(&(bar)[XB_TMO])) break; if (_sp > XB_SPIN_CAP) { atomicAdd(&(bar)[XB_TMO], 1u); break; } } } } while (0)

struct XcdBarrier {
    unsigned* bar; unsigned x;
    volatile LAS unsigned* st;
};

__device__ __forceinline__ XcdBarrier xcd_barrier_post(unsigned* bar, volatile LAS unsigned* st) {
    XcdBarrier b; b.bar = bar; b.x = xb_xcc_id(); b.st = st;
    if (threadIdx.x == 0) (void)xb_add(&bar[XB_XCNT(b.x)], 1u);
    return b;
}
__device__ __forceinline__ void xcd_barrier_complete(unsigned* bar, unsigned x, unsigned& nloc, unsigned& nx) {
    const unsigned G = gridDim.x * gridDim.y * gridDim.z;
    unsigned sum, cnt, mine, sp = 0u;
    for (;;) {
        sum = 0u; cnt = 0u; mine = 0u;
#pragma unroll
        for (unsigned j = 0; j < 16; ++j) { const unsigned c = xb_ld(&bar[XB_XCNT(j)]); sum += c; cnt += (c > 0u) ? 1u : 0u; mine = (j == x) ? c : mine; }
        if (sum == G) break;
        __builtin_amdgcn_s_sleep(1);
        if ((++sp & 255u) == 0u) { if (xb_ld(&bar[XB_TMO])) break; if (sp > XB_SPIN_CAP) { atomicAdd(&bar[XB_TMO], 1u); break; } }
    }
    nloc = mine > 0u ? mine : 1u; nx = cnt > 0u ? cnt : 1u;
}

__device__ __forceinline__ void xcd_barrier(const XcdBarrier& b) {
    asm volatile("s_waitcnt vmcnt(0)" ::: "memory");
    __syncthreads();
    if (threadIdx.x == 0) {
        unsigned* bar = b.bar;
        __builtin_amdgcn_s_waitcnt(0);
        unsigned nloc = b.st[0], nx = b.st[1];
        if (nloc == 0u) { xcd_barrier_complete(bar, b.x, nloc, nx); b.st[0] = nloc; b.st[1] = nx; }
        const unsigned old = xb_add(&bar[XB_XSUB(b.x)], 1u);
        const unsigned gen = old / nloc;
        if (old + 1u == (gen + 1u) * nloc) {
            __builtin_amdgcn_fence(__ATOMIC_RELEASE, "agent");
            asm volatile("s_waitcnt vmcnt(0)" ::: "memory");
            const unsigned og = xb_add(&bar[XB_TOP], 1u);
            const unsigned tg = og / nx;
            if (og + 1u == (tg + 1u) * nx) xb_add(&bar[XB_TOPGEN], 1u);
            else XB_SPIN(xb_ld(&bar[XB_TOPGEN]) == tg, bar);
            __builtin_amdgcn_fence(__ATOMIC_ACQUIRE, "agent");
            xb_add(&bar[XB_XGEN(b.x)], 1u);
            asm volatile("s_waitcnt vmcnt(0)" ::: "memory");
        } else {
            XB_SPIN(xb_ld(&bar[XB_XGEN(b.x)]) == gen, bar);
            __builtin_amdgcn_fence(__ATOMIC_ACQUIRE, "agent");
            asm volatile("s_waitcnt vmcnt(0)" ::: "memory");
        }
    }
    __syncthreads();
}

__device__ __forceinline__ int map_win(int ns) {
    if (ns < 1280) return ns;
    if (ns < 1304) return 6400 + (ns - 1280);
    if (ns < 2328) return 3328 + (ns - 1304);
    if (ns < 3352) { const int ch = ns - 2328; return 1280 + (ch >> 7) * 256 + (ch & 127); }
    if (ns < 4376) { const int ch = ns - 3352; return 1280 + (ch >> 7) * 256 + 128 + (ch & 127); }
    if (ns < 5400) { const int ch = ns - 4376; return 4352 + (ch >> 7) * 256 + (ch & 127); }
    { const int ch = ns - 5400; return 4352 + (ch >> 7) * 256 + 128 + (ch & 127); }
}
template <bool MAP> __device__ __forceinline__ void tr_item(const float* W, int K, int N, bf16* WT, int ldk, const float* kscale, LAS float* scr, int item, int lane) {
    const int nblk = (N + 31) / 32, kb = item / nblk, nb = item % nblk, k0 = 64 * kb, n0 = 32 * nb;
    const int nl = n0 + (lane & 31); const bool nok = nl < N;
    float tv[32];
#pragma unroll
    for (int i = 0; i < 32; ++i) { const int kk = 2 * i + (lane >> 5); tv[i] = nok ? __builtin_nontemporal_load(W + (size_t)(k0 + kk) * N + nl) : 0.f; }
#pragma unroll
    for (int i = 0; i < 32; ++i) { const int kk = 2 * i + (lane >> 5); float v = tv[i]; if (kscale) v *= kscale[k0 + kk]; scr[kk * 33 + (lane & 31)] = v; }
    LDS_WAIT(); asm volatile("" ::: "memory");
    const int c = lane & 7;
#pragma unroll
    for (int j = 0; j < 4; ++j) { const int n = (lane >> 3) + 8 * j, ns = n0 + n; const LAS float* s = scr + (8 * c) * 33 + n;
        if (ns < N) { const int dr = MAP ? map_win(ns) : ns;
            v4u o; o.x = pk2(s[0 * 33], s[1 * 33]); o.y = pk2(s[2 * 33], s[3 * 33]); o.z = pk2(s[4 * 33], s[5 * 33]); o.w = pk2(s[6 * 33], s[7 * 33]);
            *(v4u*)(WT + (size_t)dr * ldk + k0 + 8 * c) = o; } }
    LDS_WAIT(); asm volatile("" ::: "memory");
}
__device__ __forceinline__ float wave_sum(float v) {
#pragma unroll
    for (int o = 1; o < 64; o <<= 1) v += __shfl_xor(v, o);
    return v;
}

constexpr int L_KC = 0, L_VCT = 36864, L_K0 = 70144, L_V0 = 88576, L_SC = 105984, L_MB = 122368;
constexpr int KSTR = 72, VSTR = 68, VCSTR = 260;
static_assert(L_MB + 512 <= RING_BYTES, "attention LDS map");

__device__ __forceinline__ void attn_qk(const LAS unsigned char* Kb, const f32x16& cinit, const bf16x8 (&qf)[4], f32x16& p0, f32x16& p1, int r32, int hi) {
    p0 = cinit; p1 = cinit;
    bf16x8 ka[4], kb[4];
#pragma unroll
    for (int kk = 0; kk < 4; ++kk) {
        ka[kk] = *(const LAS bf16x8*)(Kb + (r32 * KSTR + 16 * kk + 8 * hi) * 2);
        kb[kk] = *(const LAS bf16x8*)(Kb + ((32 + r32) * KSTR + 16 * kk + 8 * hi) * 2);
    }
    __builtin_amdgcn_sched_barrier(0);
#pragma unroll
    for (int kk = 0; kk < 4; ++kk) { p0 = MFMA32(ka[kk], qf[kk], p0); p1 = MFMA32(kb[kk], qf[kk], p1); }
}
template <bool WIN>
__device__ __forceinline__ void attn_sp(const LAS unsigned char* Vb, int j, int cur, int tokl, unsigned long long lmask, float slope2,
                                        f32x16& p0, f32x16& p1, f32x16 (&o)[2], float& m, float& l, int r32, int hi) {
    const bool sel = (lmask >> j) & 1ull;
    const float T0 = slope2 * (float)(64 * j), T1 = T0 + 32.f * slope2;
    if (j == cur || (WIN && j == cur - 8)) {
        const int hl = (j == cur) ? tokl - 4 * hi : 99;
        const int ll = (WIN && j != cur) ? tokl - 4 * hi : -1;
#pragma unroll
        for (int r = 0; r < 16; ++r) {
            const int cr = (r & 3) + 8 * (r >> 2);
            p0[r] = (cr > ll && cr <= hl) ? p0[r] : -1e30f; p1[r] = (cr + 32 > ll && cr + 32 <= hl) ? p1[r] : -1e30f;
        }
    }
    float mx0 = fmaxf(fmaxf(p0[0], p0[1]), p0[2]), mx1 = fmaxf(fmaxf(p1[0], p1[1]), p1[2]);
#pragma unroll
    for (int r = 3; r < 15; r += 2) { mx0 = fmaxf(fmaxf(mx0, p0[r]), p0[r + 1]); mx1 = fmaxf(fmaxf(mx1, p1[r]), p1[r + 1]); }
    mx0 = fmaxf(mx0, p0[15]); mx1 = fmaxf(mx1, p1[15]);
    float bm = sel ? fmaxf(mx0 + T0, mx1 + T1) : -1e30f;
    bm = fmaxf(bm, __shfl_xor(bm, 32));
    if (__builtin_amdgcn_ballot_w64(bm > m - 20.0f) == 0ull) return;
    const float mn = fmaxf(m, bm);
    if (__builtin_amdgcn_ballot_w64(mn > m) != 0ull) {
        const float alpha = ex2(m - mn); l *= alpha;
#pragma unroll
        for (int r = 0; r < 16; ++r) { o[0][r] *= alpha; o[1][r] *= alpha; }
    }
    m = mn;
    const bool live = sel && (mn > -1e29f);
    const float c0 = live ? mn - T0 : 1e30f, c1 = live ? mn - T1 : 1e30f;
    p0 = p0 - c0; p1 = p1 - c1;
#pragma unroll
    for (int r = 0; r < 16; ++r) { p0[r] = ex2(p0[r]); p1[r] = ex2(p1[r]); }
    { const f32x16 ps = p0 + p1; l += ((ps[0] + ps[1]) + (ps[2] + ps[3])) + ((ps[4] + ps[5]) + (ps[6] + ps[7])) + ((ps[8] + ps[9]) + (ps[10] + ps[11])) + ((ps[12] + ps[13]) + (ps[14] + ps[15])); }
#pragma unroll
    for (int j4 = 0; j4 < 4; ++j4) {
        bf16x8 pb;
        if (j4 < 2) pb = pack8(p0[8 * (j4 & 1) + 0], p0[8 * (j4 & 1) + 1], p0[8 * (j4 & 1) + 2], p0[8 * (j4 & 1) + 3], p0[8 * (j4 & 1) + 4], p0[8 * (j4 & 1) + 5], p0[8 * (j4 & 1) + 6], p0[8 * (j4 & 1) + 7]);
        else        pb = pack8(p1[8 * (j4 & 1) + 0], p1[8 * (j4 & 1) + 1], p1[8 * (j4 & 1) + 2], p1[8 * (j4 & 1) + 3], p1[8 * (j4 & 1) + 4], p1[8 * (j4 & 1) + 5], p1[8 * (j4 & 1) + 6], p1[8 * (j4 & 1) + 7]);
#pragma unroll
        for (int d0 = 0; d0 < 2; ++d0) {
            const LAS unsigned char* vp = Vb + ((r32 + 32 * d0) * VSTR + 16 * j4 + 4 * hi) * 2;
            const s16x4 lo4 = *(const LAS s16x4*)vp, hi4 = *(const LAS s16x4*)(vp + 16);
            const bf16x8 a = (bf16x8){lo4[0], lo4[1], lo4[2], lo4[3], hi4[0], hi4[1], hi4[2], hi4[3]};
            o[d0] = MFMA32(a, pb, o[d0]);
        }
    }
}

template <bool WIN>
__device__ __forceinline__ void attn_branch(LAS unsigned char* L, const bf16* kvb, const bf16* vtb, unsigned long long umask, unsigned long long lmask,
                                            int cur, int tokl, float slope2, const f32x16& cinit, const bf16x8 (&qf)[4], f32x16 (&o)[2], float& l_out, int tid, int r32, int hi, bool skew, v4u k_first, v4u v_first) {
    o[0] = f32x16{}; o[1] = f32x16{}; float m = -1e30f, l = 0.f;
    const int srow = tid >> 3, sch = tid & 7;
    unsigned long long pend = umask;
#define POP(dst) do { if (pend) { dst = 63 - __builtin_clzll(pend); pend &= ~(1ull << dst); } else dst = -1; } while (0)
#define STAGE_LOAD(kr, vr, jj) do { kr = *(const v4u*)(kvb + (size_t)(64 * (jj) + srow) * 768 + sch * 8); vr = *(const v4u*)(vtb + (size_t)srow * SEQ + 64 * (jj) + sch * 8); } while (0)
#define STAGE_WRITE(kso, vso, kr, vr) do { \
        *(LAS v4u*)(L + L_K0 + (kso) + (srow * KSTR + sch * 8) * 2) = kr; \
        LAS v2u* vt_ = (LAS v2u*)(L + L_V0 + (vso) + (srow * VSTR + sch * 8) * 2); \
        vt_[0] = (v2u){vr.x, vr.y}; vt_[1] = (v2u){vr.z, vr.w}; } while (0)
    int jq0, jq1; POP(jq0); POP(jq1);
    v4u kA = k_first, vA = v_first;
    STAGE_WRITE(0, 0, kA, vA);
    if (jq1 >= 0) STAGE_LOAD(kA, vA, jq1);
    __syncthreads();
    int kso = 0, vso = 0, vsn = 8704, vsp = 0, jprev = -1;
    f32x16 p0, p1;
    for (;;) {
        int jq2 = -1;
        if (jq1 >= 0) { STAGE_WRITE(kso ^ 9216, vsn, kA, vA); POP(jq2); if (jq2 >= 0) STAGE_LOAD(kA, vA, jq2); }
        if (skew) {
            if (jprev >= 0) attn_sp<WIN>(L + L_V0 + vsp, jprev, cur, tokl, lmask, slope2, p0, p1, o, m, l, r32, hi);
            attn_qk(L + L_K0 + kso, cinit, qf, p0, p1, r32, hi);
        } else {
            attn_qk(L + L_K0 + kso, cinit, qf, p0, p1, r32, hi);
            attn_sp<WIN>(L + L_V0 + vso, jq0, cur, tokl, lmask, slope2, p0, p1, o, m, l, r32, hi);
        }
        __syncthreads();
        jprev = jq0; vsp = vso; vso = vsn; vsn = (vsn == 2 * 8704) ? 0 : vsn + 8704; kso ^= 9216;
        if (jq1 < 0) break;
        jq0 = jq1; jq1 = jq2;
    }
    if (skew) attn_sp<WIN>(L + L_V0 + vsp, jprev, cur, tokl, lmask, slope2, p0, p1, o, m, l, r32, hi);
    __syncthreads();
#undef POP
#undef STAGE_LOAD
#undef STAGE_WRITE
    l_out = l + __shfl_xor(l, 32);
}

struct AttnPtrs { const bf16 *Q, *KV, *GN, *KCN, *VCT, *VT; bf16* O; const float* qg; };

__device__ __forceinline__ void attn_unit(const AttnPtrs& A, LAS unsigned char* L, int b, int g, int cur) {
    int tid_ = threadIdx.x; asm volatile("" : "+v"(tid_));
    const int tid = tid_, lane = tid & 63, w = __builtin_amdgcn_readfirstlane(tid >> 6), r32 = lane & 31, hi = lane >> 5;
    const int tokl = 8 * w + (r32 >> 2), head = r32 & 3, hq = g * 4 + head, t = 64 * cur + tokl;
    const size_t mrow = (size_t)b * SEQ + t;
    const float slope2 = ex2(-(float)(hq + 1)) * LOG2E;
    bf16x8 qf[4];
    {
        const bf16* qp = A.Q + mrow * 512 + hq * 64 + 8 * hi;
        v4u qw[4]; float ss = 0.f;
#pragma unroll
        for (int kk = 0; kk < 4; ++kk) qw[kk] = *(const v4u*)(qp + 16 * kk);
#pragma unroll
        for (int kk = 0; kk < 4; ++kk) { const v4u w_ = qw[kk];
            ss += (blo(w_.x) * blo(w_.x) + bhi(w_.x) * bhi(w_.x)) + (blo(w_.y) * blo(w_.y) + bhi(w_.y) * bhi(w_.y)) + (blo(w_.z) * blo(w_.z) + bhi(w_.z) * bhi(w_.z)) + (blo(w_.w) * blo(w_.w) + bhi(w_.w) * bhi(w_.w)); }
        ss += __shfl_xor(ss, 32);
        const float rq = __builtin_amdgcn_rsqf(ss * (1.f / 64.f) + EPS) * (0.125f * LOG2E);
#pragma unroll
        for (int kk = 0; kk < 4; ++kk) { const v4u w_ = qw[kk]; const f32x4 ga = *(const f32x4*)(A.qg + 16 * kk + 8 * hi), gb = *(const f32x4*)(A.qg + 16 * kk + 8 * hi + 4);
            qf[kk] = pack8(blo(w_.x) * rq * ga[0], bhi(w_.x) * rq * ga[1], blo(w_.y) * rq * ga[2], bhi(w_.y) * rq * ga[3], blo(w_.z) * rq * gb[0], bhi(w_.z) * rq * gb[1], blo(w_.w) * rq * gb[2], bhi(w_.w) * rq * gb[3]); }
    }
    const float g0 = bf2f(A.GN[mrow * 32 + hq]), g1 = bf2f(A.GN[mrow * 32 + 8 + hq]), g2 = bf2f(A.GN[mrow * 32 + 16 + hq]);
    const int ncv = (4 * cur + 3 < 255) ? 4 * cur + 3 : 255, nblk = (ncv + 31) >> 5, nrow = nblk * 32;
    v4u kr[4], vr[4];
    {
        const bf16* kc = A.KCN + (size_t)(b * 2 + g) * 256 * 64; const bf16* vc = A.VCT + (size_t)(b * 2 + g) * 64 * 256;
#pragma unroll
        for (int i = 0; i < 4; ++i) {
            const int ck = i * 512 + tid, row = ck >> 3;
            kr[i] = (row < nrow) ? *(const v4u*)(kc + (size_t)ck * 8) : (v4u){0u, 0u, 0u, 0u};
            const int d = ck >> 5, cc = (ck & 31) * 8;
            vr[i] = (cc < nrow) ? *(const v4u*)(vc + (size_t)d * 256 + cc) : (v4u){0u, 0u, 0u, 0u};
        }
    }
    __syncthreads();
    {
#pragma unroll
        for (int i = 0; i < 4; ++i) {
            const int ck = i * 512 + tid, row = ck >> 3, d = ck >> 5, cc = (ck & 31) * 8;
            if (row < nrow) *(LAS v4u*)(L + L_KC + (row * KSTR + (ck & 7) * 8) * 2) = kr[i];
            if (cc < nrow) { LAS v2u* vp = (LAS v2u*)(L + L_VCT + (d * VCSTR + cc) * 2); vp[0] = (v2u){vr[i].x, vr[i].y}; vp[1] = (v2u){vr[i].z, vr[i].w}; }
        }
    }
    __syncthreads();
    f32x16 cinit;
#pragma unroll
    for (int r = 0; r < 16; ++r) cinit[r] = slope2 * (float)((r & 3) + 8 * (r >> 2) + 4 * hi);
    const int clim_l = ((t - 31) >> 4) - 4 * hi;
    const bool need_imp = cur >= 16;
    LAS f32x4* park = (LAS f32x4*)(L + w * 8192) + lane;
    float imp[33];
#pragma unroll
    for (int i = 0; i < 33; ++i) imp[i] = 0.f;
    {
        f32x16 oc[2]; oc[0] = f32x16{}; oc[1] = f32x16{};
        float m1 = -1e30f, l1 = 0.f;
#pragma unroll
        for (int bi = 0; bi < 8; ++bi) {
            const int blk = 7 - bi;
            if (blk < nblk) {
                f32x16 p = f32x16{};
                { bf16x8 kc4[4];
#pragma unroll
                  for (int kk = 0; kk < 4; ++kk) kc4[kk] = *(const LAS bf16x8*)(L + L_KC + ((32 * blk + r32) * KSTR + 16 * kk + 8 * hi) * 2);
                  __builtin_amdgcn_sched_barrier(0);
#pragma unroll
                  for (int kk = 0; kk < 4; ++kk) p = MFMA32(kc4[kk], qf[kk], p); }
                if (32 * blk + 31 > 4 * cur - 2) {
#pragma unroll
                    for (int r = 0; r < 16; ++r) p[r] = (32 * blk + (r & 3) + 8 * (r >> 2) <= clim_l) ? fmaf(cinit[r], 16.f, p[r]) : -1e30f;
                } else {
#pragma unroll
                    for (int r = 0; r < 16; ++r) p[r] = fmaf(cinit[r], 16.f, p[r]);
                }
                const float Tb = slope2 * 512.f * (float)blk;
                float mx = fmaxf(fmaxf(p[0], p[1]), p[2]);
#pragma unroll
                for (int r = 3; r < 15; r += 2) mx = fmaxf(fmaxf(mx, p[r]), p[r + 1]);
                mx = fmaxf(mx, p[15]);
                float bm = mx + Tb; bm = fmaxf(bm, __shfl_xor(bm, 32));
                const float mn = fmaxf(m1, bm);
                if (__builtin_amdgcn_ballot_w64(mn > m1) != 0ull) {
                    const float alpha = ex2(m1 - mn); l1 *= alpha;
#pragma unroll
                    for (int r = 0; r < 16; ++r) { oc[0][r] *= alpha; oc[1][r] *= alpha; }
                    if (need_imp) {
#pragma unroll
                        for (int i = 0; i < 33; ++i) imp[i] *= alpha;
                    }
                }
                m1 = mn;
                const float c2 = (mn > -1e29f) ? mn - Tb : 1e30f;
                float rs = 0.f;
#pragma unroll
                for (int r = 0; r < 16; ++r) { p[r] = ex2(p[r] - c2); rs += p[r]; }
                l1 += rs;
                if (need_imp) {
#pragma unroll
                    for (int a = 0; a < 4; ++a) {
                        const float sp = 0.5f * p[4 * a + 3], v = p[4 * a] + p[4 * a + 1] + p[4 * a + 2] + sp, rc = __shfl_xor(sp, 32);
                        imp[4 * blk + a] += v + (hi ? rc : 0.f); imp[4 * blk + a + 1] += (hi ? 0.f : rc);
                    }
                }
#pragma unroll
                for (int j2 = 0; j2 < 2; ++j2) {
                    const bf16x8 pb = pack8(p[8 * j2 + 0], p[8 * j2 + 1], p[8 * j2 + 2], p[8 * j2 + 3], p[8 * j2 + 4], p[8 * j2 + 5], p[8 * j2 + 6], p[8 * j2 + 7]);
#pragma unroll
                    for (int d0 = 0; d0 < 2; ++d0) {
                        const LAS unsigned char* vp = L + L_VCT + ((r32 + 32 * d0) * VCSTR + 32 * blk + 16 * j2 + 4 * hi) * 2;
                        const s16x4 lo4 = *(const LAS s16x4*)vp, hi4 = *(const LAS s16x4*)(vp + 16);
                        const bf16x8 a = (bf16x8){lo4[0], lo4[1], lo4[2], lo4[3], hi4[0], hi4[1], hi4[2], hi4[3]};
                        oc[d0] = MFMA32(a, pb, oc[d0]);
                    }
                }
            }
        }
        const float Lt = l1 + __shfl_xor(l1, 32), inv = 1.0f / fmaxf(Lt, 1e-30f), gi = g0 * inv;
        __syncthreads();
#pragma unroll
        for (int k = 0; k < 4; ++k) {
            park[64 * k] = (f32x4){gi * oc[0][4 * k], gi * oc[0][4 * k + 1], gi * oc[0][4 * k + 2], gi * oc[0][4 * k + 3]};
            park[64 * (4 + k)] = (f32x4){gi * oc[1][4 * k], gi * oc[1][4 * k + 1], gi * oc[1][4 * k + 2], gi * oc[1][4 * k + 3]};
        }
        if (need_imp) {
#pragma unroll
            for (int i = 0; i < 32; ++i) imp[i] *= inv;
        }
    }
    const bf16* kvb = A.KV + (size_t)b * SEQ * 768 + g * 64;
    const bf16* vts = A.VT + (size_t)((b * 2 + 0) * 2 + g) * 64 * SEQ; const bf16* vtw = A.VT + (size_t)((b * 2 + 1) * 2 + g) * 64 * SEQ;
    const v4u ks0 = *(const v4u*)(kvb + 256 + (size_t)(64 * cur + (tid >> 3)) * 768 + (tid & 7) * 8), vs0 = *(const v4u*)(vts + (size_t)(tid >> 3) * SEQ + 64 * cur + (tid & 7) * 8);
    const unsigned long long causal = (cur >= 63) ? ~0ull : ((2ull << cur) - 1ull);
    unsigned long long lmask = causal, umask = causal;
    if (cur >= 16) {
#pragma unroll
        for (int i = 0; i < 32; ++i) { imp[i] += __shfl_xor(imp[i], 1); imp[i] += __shfl_xor(imp[i], 2); }
        if (head == 0) {
            LAS unsigned* sc = (LAS unsigned*)(L + L_SC) + tokl * 64 + hi;
#pragma unroll
            for (int i = 0; i < 32; ++i) { const int jj = 2 * i + hi; const bool forced = (jj == 0) || (jj == cur) || (jj == cur - 1);
                const unsigned kb = forced ? __float_as_uint(1e4f) : ((jj <= cur) ? __float_as_uint(imp[i]) : 0u); sc[2 * i] = (kb & ~63u) | (unsigned)(63 - jj); }
        }
        __syncthreads();
        {
            const int tok = tid >> 3, part = tid & 7; const LAS unsigned* row = (const LAS unsigned*)(L + L_SC) + tok * 64;
            unsigned mine[8]; int rank[8];
#pragma unroll
            for (int e = 0; e < 8; ++e) { mine[e] = row[part * 8 + e]; rank[e] = 0; }
            for (int jj = 0; jj <= cur; jj += 4) {
                const v4u k4 = *(const LAS v4u*)(row + jj);
#pragma unroll
                for (int q = 0; q < 4; ++q) {
#pragma unroll
                    for (int e = 0; e < 8; ++e) rank[e] += (k4[q] > mine[e]) ? 1 : 0;
                }
            }
            unsigned bits = 0u;
#pragma unroll
            for (int e = 0; e < 8; ++e) bits |= (rank[e] < 16 ? 1u : 0u) << e;
            ((LAS unsigned char*)(L + L_MB))[tok * 8 + part] = (unsigned char)bits;
        }
        __syncthreads();
        const v2u mw = *(const LAS v2u*)(L + L_MB + tokl * 8);
        lmask = (((unsigned long long)mw.y << 32) | mw.x) & causal;
        v2u uw = *(const LAS v2u*)(L + L_MB + lane * 8);
#pragma unroll
        for (int o_ = 1; o_ < 64; o_ <<= 1) { uw.x |= (unsigned)__shfl_xor((int)uw.x, o_); uw.y |= (unsigned)__shfl_xor((int)uw.y, o_); }
        umask = ((((unsigned long long)(unsigned)__builtin_amdgcn_readfirstlane((int)uw.y)) << 32) | (unsigned)__builtin_amdgcn_readfirstlane((int)uw.x)) & causal;
    }
    v4u kw0, vw0;
    {
        f32x16 o[2]; float lt;
        attn_branch<false>(L, kvb + 256, vts, umask, lmask, cur, tokl, slope2, cinit, qf, o, lt, tid, r32, hi, false, ks0, vs0);
        kw0 = *(const v4u*)(kvb + 512 + (size_t)(64 * cur + (tid >> 3)) * 768 + (tid & 7) * 8); vw0 = *(const v4u*)(vtw + (size_t)(tid >> 3) * SEQ + 64 * cur + (tid & 7) * 8);
        const float sc = g1 / lt;
#pragma unroll
        for (int k = 0; k < 4; ++k) {
            park[64 * k] += (f32x4){sc * o[0][4 * k], sc * o[0][4 * k + 1], sc * o[0][4 * k + 2], sc * o[0][4 * k + 3]};
            park[64 * (4 + k)] += (f32x4){sc * o[1][4 * k], sc * o[1][4 * k + 1], sc * o[1][4 * k + 2], sc * o[1][4 * k + 3]};
        }
    }
    {
        const int jlo = (cur >= 8) ? cur - 8 : 0;
        const unsigned long long wmask = causal & ~((1ull << jlo) - 1ull);
        f32x16 o[2]; float lt;
                attn_branch<true>(L, kvb + 512, vtw, wmask, ~0ull, cur, tokl, slope2, cinit, qf, o, lt, tid, r32, hi, false, kw0, vw0);
        const float sc = g2 / lt;
        bf16* op = A.O + mrow * 1536 + hq * 64 + 4 * hi;
#pragma unroll
        for (int d0 = 0; d0 < 2; ++d0)
#pragma unroll
            for (int a = 0; a < 4; ++a) {
                const f32x4 pv = park[64 * (4 * d0 + a)];
                v2u wv; wv.x = pk2(pv[0] + sc * o[d0][4 * a], pv[1] + sc * o[d0][4 * a + 1]); wv.y = pk2(pv[2] + sc * o[d0][4 * a + 2], pv[3] + sc * o[d0][4 * a + 3]);
                *(v2u*)(op + 32 * d0 + 8 * a) = wv;
            }
    }
}

__global__ void __launch_bounds__(NWAVES * 64, 2) nsa_block_fwd(Args a) {
    extern __shared__ __attribute__((aligned(16))) unsigned char lds_raw[];
    cg::grid_group grid = cg::this_grid();
    LAS unsigned char* lds = (LAS unsigned char*)lds_raw;
    const int tid = threadIdx.x, lane = tid & 63, wave = __builtin_amdgcn_readfirstlane(tid >> 6);
    const int G = gridDim.x, bx = blockIdx.x, vcu = (G % 8 == 0) ? (bx % 8) * (G / 8) + bx / 8 : bx;
    unsigned char* ws = a.ws;
    float* rowss = (float*)(ws + WS_ROWSS);
    bf16 *WIN_t = (bf16*)(ws + WS_WIN), *WAB_t = (bf16*)(ws + WS_WAB), *WO_t = (bf16*)(ws + WS_WO), *WUP_t = (bf16*)(ws + WS_WUP), *WDN_t = (bf16*)(ws + WS_WDN);
    bf16 *WC_t = (bf16*)(ws + WS_WC);
    bf16 *KCN = (bf16*)(ws + WS_KCN), *VCT = (bf16*)(ws + WS_VCT), *VT = (bf16*)(ws + WS_VT);
    bf16 *GN = (bf16*)(ws + WS_GN), *XN = (bf16*)(ws + WS_XN), *QB = (bf16*)(ws + WS_Q), *KVB = (bf16*)(ws + WS_KV), *UB = (bf16*)(ws + WS_U), *CB = (bf16*)(ws + WS_CB);
    bf16 *GA = (bf16*)a.out, *GB = (bf16*)a.out + (size_t)M * 1024, *ZO = (bf16*)(ws + WS_ZO), *MIX = (bf16*)(ws + WS_MIX), *HB = (bf16*)(ws + WS_H);
    const int gw = vcu * NWAVES + wave, NGW = G * NWAVES;
    unsigned* barw = (unsigned*)(ws + WS_BAR);
    for (int u = tid; u < (LDS_BYTES - RING_BYTES) / 4; u += NWAVES * 64) ((LAS unsigned*)(lds + RING_BYTES))[u] = 0u;
    __syncthreads();
    const XcdBarrier xbar = xcd_barrier_post(barw, (volatile LAS unsigned*)(lds + MISC_OFF) + 8);
    if (a.never) grid.sync();

    {
        LAS float* scr = (LAS float*)(lds + wave * 16384);
        constexpr int I_IN = 16 * 201, I_A = 8 * 32, I_B = 16 * 32, I_O = 16 * 32, I_UP = 16 * 128, I_DN = 64 * 32, I_C = 32 * 2;
        constexpr int I_PAD = NPAD - NPROJ, I_Z = M / 4096;
        constexpr int NITEMS = I_IN + I_A + I_B + I_O + I_UP + I_DN + 2 * I_C + I_PAD + I_Z;
        for (int it = gw; it < NITEMS; it += NGW) {
            int r = it;
            if (r < I_IN) { tr_item<true>(a.w_in, 1024, NPROJ, WIN_t, 1024, nullptr, scr, r, lane); continue; } r -= I_IN;
            if (r < I_A) { tr_item<false>(a.w_branch_a, 512, 1024, WAB_t, 1536, nullptr, scr, r, lane); continue; } r -= I_A;
            if (r < I_B) { tr_item<false>(a.w_branch_b, 1024, 1024, WAB_t + 512, 1536, nullptr, scr, r, lane); continue; } r -= I_B;
            if (r < I_O) { tr_item<false>(a.w_out, 1024, 1024, WO_t, 1024, nullptr, scr, r, lane); continue; } r -= I_O;
            if (r < I_UP) { tr_item<false>(a.w_up, 1024, 4096, WUP_t, 1024, a.norm2_g, scr, r, lane); continue; } r -= I_UP;
            if (r < I_DN) { tr_item<false>(a.w_down, 4096, 1024, WDN_t, 4096, nullptr, scr, r, lane); continue; } r -= I_DN;
            if (r < I_C) { tr_item<false>(a.w_cmp_k, 2048, 64, WC_t, 2048, nullptr, scr, r, lane); continue; } r -= I_C;
            if (r < I_C) { tr_item<false>(a.w_cmp_v, 2048, 64, WC_t + 64 * 2048, 2048, nullptr, scr, r, lane); continue; } r -= I_C;
            if (r < I_PAD) { v4u z = (v4u){0u, 0u, 0u, 0u}; v4u* p = (v4u*)(WIN_t + (size_t)(NPROJ + r) * 1024) + lane * 2; p[0] = z; p[1] = z; continue; } r -= I_PAD;
            { f32x4 z = (f32x4){0.f, 0.f, 0.f, 0.f}; f32x4* p = (f32x4*)(rowss + (size_t)r * 4096) + lane;
#pragma unroll
              for (int i = 0; i < 16; ++i) p[64 * i] = z; }
        }
        for (int m = gw; m < M; m += 4 * NGW) {
            const f32x4* gr = (const f32x4*)a.norm1_g + lane;
            f32x4 v[4][4];
#pragma unroll
            for (int q = 0; q < 4; ++q) { const int mm = (m + q * NGW < M) ? m + q * NGW : m; const f32x4* xr = (const f32x4*)(a.x + (size_t)mm * DM) + lane;
#pragma unroll
                for (int j = 0; j < 4; ++j) v[q][j] = __builtin_nontemporal_load(xr + 64 * j); }
#pragma unroll
            for (int q = 0; q < 4; ++q) {
                float sq = 0.f;
#pragma unroll
                for (int j = 0; j < 4; ++j) sq += (v[q][j].x * v[q][j].x + v[q][j].y * v[q][j].y) + (v[q][j].z * v[q][j].z + v[q][j].w * v[q][j].w);
                const float rstd = __builtin_amdgcn_rsqf(wave_sum(sq) * (1.f / DM) + EPS);
                if (m + q * NGW < M) {
                    v2u* o8 = (v2u*)(XN + (size_t)(m + q * NGW) * DM) + lane;
#pragma unroll
                    for (int j = 0; j < 4; ++j) { const f32x4 gg = gr[64 * j]; v2u wv; wv.x = pk2(v[q][j].x * rstd * gg.x, v[q][j].y * rstd * gg.y); wv.y = pk2(v[q][j].z * rstd * gg.z, v[q][j].w * rstd * gg.w); o8[64 * j] = wv; }
                }
            }
        }
    }
    xcd_barrier(xbar);

    {
        pg8::Gemm g{XN, WIN_t, M, NPAD, 1024}; pg8::StaticOrder S; S.init(M, NPAD, G, bx);
        pg8::EpiProj E{QB, KVB, UB, CB, GA, GB, GN, VT};
        pg8::gemm_phase<pg8::EpiProj, pg8::StaticOrder, true, true>(lds, g, S, E);
    }
    xcd_barrier(xbar);

    {
        const int r32 = lane & 31, hi = lane >> 5;
        const int e0 = (lane & 7) * 8;
        float kgv[8];
#pragma unroll
        for (int e = 0; e < 8; ++e) kgv[e] = a.k_norm_g[64 * (1 + ((lane >> 4) & 1)) + e0 + e];
        for (int rb = gw; rb < M / 16; rb += NGW) {
            const int m0 = rb * 16, tt0 = m0 & (SEQ - 1), bb = m0 / SEQ;
            const int kcol = (((lane >> 4) & 1) ? 512 : 256) + (lane & 15) * 8;
#pragma unroll 1
            for (int k4 = 0; k4 < 16; k4 += 4) {
                v4u kw[4];
#pragma unroll
                for (int i = 0; i < 4; ++i) { kw[i] = (v4u){0u, 0u, 0u, 0u}; if (lane < 32) kw[i] = *(const v4u*)(KVB + (size_t)(m0 + k4 + i) * 768 + kcol); }
#pragma unroll
                for (int i = 0; i < 4; ++i) {
                    const v4u w = kw[i];
                    float f[8] = {blo(w.x), bhi(w.x), blo(w.y), bhi(w.y), blo(w.z), bhi(w.z), blo(w.w), bhi(w.w)};
                    float ss = 0.f;
#pragma unroll
                    for (int e = 0; e < 8; ++e) ss += f[e] * f[e];
                    ss += __shfl_xor(ss, 1); ss += __shfl_xor(ss, 2); ss += __shfl_xor(ss, 4);
                    const float rstd = __builtin_amdgcn_rsqf(ss * (1.f / 64.f) + EPS);
                    v4u o; o.x = pk2(f[0] * rstd * kgv[0], f[1] * rstd * kgv[1]); o.y = pk2(f[2] * rstd * kgv[2], f[3] * rstd * kgv[3]); o.z = pk2(f[4] * rstd * kgv[4], f[5] * rstd * kgv[5]); o.w = pk2(f[6] * rstd * kgv[6], f[7] * rstd * kgv[7]);
                    if (lane < 32) *(v4u*)(KVB + (size_t)(m0 + k4 + i) * 768 + kcol) = o;
                }
            }
#pragma unroll 1
            for (int h = 0; h < 2; ++h) {
                const int ch = (h * 64 + lane) * 8;
                const f32x4 wa0 = *(const f32x4*)(a.conv_w + ch), wa1 = *(const f32x4*)(a.conv_w + ch + 4);
                const f32x4 wb0 = *(const f32x4*)(a.conv_w + 1024 + ch), wb1 = *(const f32x4*)(a.conv_w + 1024 + ch + 4);
                const f32x4 wc0 = *(const f32x4*)(a.conv_w + 2048 + ch), wc1 = *(const f32x4*)(a.conv_w + 2048 + ch + 4);
                v4u u1 = (v4u){0u, 0u, 0u, 0u}, u2 = (v4u){0u, 0u, 0u, 0u};
                if (tt0 != 0) { u1 = *(const v4u*)(UB + (size_t)(m0 - 1) * 1024 + ch); u2 = *(const v4u*)(UB + (size_t)(m0 - 2) * 1024 + ch); }
#pragma unroll 1
                for (int k4 = 0; k4 < 16; k4 += 4) {
                    v4u uu[4], cbv[4];
#pragma unroll
                    for (int i = 0; i < 4; ++i) { uu[i] = *(const v4u*)(UB + (size_t)(m0 + k4 + i) * 1024 + ch); cbv[i] = *(const v4u*)(CB + (size_t)(m0 + k4 + i) * 1024 + ch); }
#pragma unroll
                    for (int i = 0; i < 4; ++i) {
                        const v4u u0 = uu[i], cb = cbv[i]; v4u o;
                        o.x = pk2(blo(cb.x) * (wa0[0] * blo(u2.x) + wb0[0] * blo(u1.x) + wc0[0] * blo(u0.x)), bhi(cb.x) * (wa0[1] * bhi(u2.x) + wb0[1] * bhi(u1.x) + wc0[1] * bhi(u0.x)));
                        o.y = pk2(blo(cb.y) * (wa0[2] * blo(u2.y) + wb0[2] * blo(u1.y) + wc0[2] * blo(u0.y)), bhi(cb.y) * (wa0[3] * bhi(u2.y) + wb0[3] * bhi(u1.y) + wc0[3] * bhi(u0.y)));
                        o.z = pk2(blo(cb.z) * (wa1[0] * blo(u2.z) + wb1[0] * blo(u1.z) + wc1[0] * blo(u0.z)), bhi(cb.z) * (wa1[1] * bhi(u2.z) + wb1[1] * bhi(u1.z) + wc1[1] * bhi(u0.z)));
                        o.w = pk2(blo(cb.w) * (wa1[2] * blo(u2.w) + wb1[2] * blo(u1.w) + wc1[2] * blo(u0.w)), bhi(cb.w) * (wa1[3] * bhi(u2.w) + wb1[3] * bhi(u1.w) + wc1[3] * bhi(u0.w)));
                        *(v4u*)(ZO + (size_t)(m0 + k4 + i) * 1536 + 512 + ch) = o;
                        u2 = u1; u1 = u0;
                    }
                }
            }
        }
        for (int task = vcu; task < 256; task += G) {
            const int mat = task >> 7, rt = task & 127;
            const int R = rt * 32 + r32, bb = R >> 9, cc = (R >> 1) & 255, gg = R & 1;
            const bf16* abase = KVB + (size_t)(bb * SEQ + 16 * cc) * 768 + mat * 128 + gg * 64 + 8 * hi;
            const float* pos = (mat ? a.cmp_pos_v : a.cmp_pos_k) + 8 * hi;
            const bf16* wb = WC_t + (size_t)mat * (64 * 2048) + (size_t)r32 * 2048 + 8 * hi;
            f32x16 acc0 = f32x16{}, acc1 = f32x16{};
#pragma unroll
            for (int i = 0; i < 16; ++i) {
                const int kk = wave * 16 + i, l = kk >> 2, dd = (kk & 3) * 16;
                const v4u av = *(const v4u*)(abase + (size_t)l * 768 + dd);
                const f32x4 q0 = *(const f32x4*)(pos + l * 64 + dd), q1 = *(const f32x4*)(pos + l * 64 + dd + 4);
                const bf16x8 ap = pack8(blo(av.x) + q0[0], bhi(av.x) + q0[1], blo(av.y) + q0[2], bhi(av.y) + q0[3], blo(av.z) + q1[0], bhi(av.z) + q1[1], blo(av.w) + q1[2], bhi(av.w) + q1[3]);
                const bf16x8 b0 = *(const bf16x8*)(wb + 16 * kk), b1 = *(const bf16x8*)(wb + 32 * 2048 + 16 * kk);
                acc0 = MFMA32(ap, b0, acc0); acc1 = MFMA32(ap, b1, acc1);
            }
            LAS float* red = (LAS float*)lds + wave * 2048;
#pragma unroll
            for (int r = 0; r < 16; ++r) { red[crow(r, hi) * 64 + r32] = acc0[r]; red[crow(r, hi) * 64 + 32 + r32] = acc1[r]; }
            __syncthreads();
            {
                const int row = tid >> 4, c4 = (tid & 15) * 4;
                f32x4 sm = (f32x4){0.f, 0.f, 0.f, 0.f};
#pragma unroll
                for (int w8 = 0; w8 < 8; ++w8) sm += *(const LAS f32x4*)((LAS float*)lds + w8 * 2048 + row * 64 + c4);
                const int R2 = rt * 32 + row, b2 = R2 >> 9, c2 = (R2 >> 1) & 255, g2 = R2 & 1;
                if (c2 == 255) sm = (f32x4){0.f, 0.f, 0.f, 0.f};
                if (mat == 0) {
                    float ss = (sm[0] * sm[0] + sm[1] * sm[1]) + (sm[2] * sm[2] + sm[3] * sm[3]);
                    ss += __shfl_xor(ss, 1); ss += __shfl_xor(ss, 2); ss += __shfl_xor(ss, 4); ss += __shfl_xor(ss, 8);
                    const float rstd = __builtin_amdgcn_rsqf(ss * (1.f / 64.f) + EPS);
                    const f32x4 kg = *(const f32x4*)(a.k_norm_g + c4);
                    v2u o; o.x = pk2(sm[0] * rstd * kg[0], sm[1] * rstd * kg[1]); o.y = pk2(sm[2] * rstd * kg[2], sm[3] * rstd * kg[3]);
                    *(v2u*)(KCN + ((size_t)((b2 * 2 + g2) * 256 + c2)) * 64 + c4) = o;
                } else {
                    bf16* vo = VCT + ((size_t)(b2 * 2 + g2) * 64 + c4) * 256 + c2;
                    const unsigned w0 = pk2(sm[0], sm[1]), w1 = pk2(sm[2], sm[3]);
                    vo[0] = (bf16)(w0 & 0xffffu); vo[256] = (bf16)(w0 >> 16); vo[512] = (bf16)(w1 & 0xffffu); vo[768] = (bf16)(w1 >> 16);
                }
            }
            __syncthreads();
        }
    }
    xcd_barrier(xbar);

    {
        const AttnPtrs A{QB, KVB, GN, KCN, VCT, VT, ZO, a.q_norm_g};
        volatile LAS int* qslot = (volatile LAS int*)(lds + MISC_OFF) + 16;
        unsigned* queue = barw + XCD_BAR_WORDS + 64;
        int idx = bx;
        while (idx < 1024) {
            int nxt = 0;
            if (tid == 0) nxt = (int)atomicAdd(queue, 1u) + G;
            int b_, g_, cur_;
            if (idx < 368) { g_ = 1; cur_ = 63 - (idx >> 3); b_ = idx & 7; }
            else if (idx < 752) { const int r2 = idx - 368; if (r2 < 376) { g_ = 0; cur_ = 63 - (r2 >> 3); b_ = r2 & 7; } else { g_ = 1; cur_ = 17; b_ = r2 - 376; } }
            else { const int r3 = idx - 752; cur_ = 16 - (r3 >> 4); g_ = (r3 >> 3) & 1; b_ = r3 & 7; }
            attn_unit(A, lds, b_, g_, cur_);
            if (tid == 0) qslot[0] = nxt;
            __syncthreads();
            idx = qslot[0];
            __syncthreads();
        }
    }
    xcd_barrier(xbar);

    {
        pg8::Gemm g{ZO, WAB_t, M, 1024, 1536}; pg8::StaticOrder S; S.init(M, 1024, G, bx);
        pg8::EpiMix E{GA, GB, MIX, 1024};
        pg8::gemm_phase<pg8::EpiMix, pg8::StaticOrder, true, true>(lds, g, S, E);
    }
    xcd_barrier(xbar);
    {
        pg8::Gemm g{MIX, WO_t, M, 1024, 1024}; pg8::StaticOrder S; S.init(M, 1024, G, bx);
        pg8::EpiX1 E{a.x, XN, rowss};
        pg8::gemm_phase<pg8::EpiX1, pg8::StaticOrder, true, true>(lds, g, S, E);
    }
    xcd_barrier(xbar);
    {
        pg8::Gemm g{XN, WUP_t, M, DFF, 1024}; pg8::StaticOrder S; S.init(M, DFF, G, bx);
        pg8::EpiUp E{rowss, HB, DFF, {}};
        pg8::gemm_phase<pg8::EpiUp, pg8::StaticOrder, true, true>(lds, g, S, E);
    }
    xcd_barrier(xbar);
    {
        pg8::Gemm g{HB, WDN_t, M, 1024, DFF}; pg8::StaticOrder S; S.init(M, 1024, G, bx);
        pg8::EpiDown E{XN, a.out};
        pg8::gemm_phase<pg8::EpiDown, pg8::StaticOrder, true, true>(lds, g, S, E);
    }
}

extern "C" void kernel_launch(void* const* d_in, const int* in_sizes, int n_in, void* d_out, int out_size, void* d_ws, size_t ws_size, hipStream_t stream) {
    static int grid = 0;
    if (grid == 0) {
        if (n_in != 16 || out_size != M * DM || ws_size < WS_END) { fprintf(stderr, "kernel_launch: unexpected shapes (n_in %d, out %d, ws %zu)\n", n_in, out_size, ws_size); grid = -1; return; }
        int dev = 0, cus = 0, per_cu = 0;
        (void)hipGetDevice(&dev); (void)hipDeviceGetAttribute(&cus, hipDeviceAttributeMultiprocessorCount, dev);
        if (hipFuncSetAttribute((const void*)nsa_block_fwd, hipFuncAttributeMaxDynamicSharedMemorySize, LDS_BYTES) != hipSuccess) { fprintf(stderr, "kernel_launch: hipFuncSetAttribute failed\n"); grid = -1; return; }
        if (hipOccupancyMaxActiveBlocksPerMultiprocessor(&per_cu, (const void*)nsa_block_fwd, NWAVES * 64, LDS_BYTES) != hipSuccess || per_cu < 1) { fprintf(stderr, "kernel_launch: occupancy query says %d\n", per_cu); per_cu = 1; }
        (void)hipGetLastError();
        grid = cus * 1;
    }
    if (grid < 0) return;
    if (hipMemsetAsync((char*)d_ws + WS_BAR, 0, (XCD_BAR_WORDS + 128) * sizeof(unsigned), stream) != hipSuccess) { fprintf(stderr, "kernel_launch: hipMemsetAsync failed\n"); return; }
    Args a{};
    a.x = (const float*)d_in[0]; a.norm1_g = (const float*)d_in[1]; a.w_in = (const float*)d_in[2]; a.q_norm_g = (const float*)d_in[3]; a.k_norm_g = (const float*)d_in[4];
    a.cmp_pos_k = (const float*)d_in[5]; a.cmp_pos_v = (const float*)d_in[6]; a.w_cmp_k = (const float*)d_in[7]; a.w_cmp_v = (const float*)d_in[8]; a.conv_w = (const float*)d_in[9];
    a.w_branch_a = (const float*)d_in[10]; a.w_branch_b = (const float*)d_in[11]; a.w_out = (const float*)d_in[12]; a.norm2_g = (const float*)d_in[13]; a.w_up = (const float*)d_in[14]; a.w_down = (const float*)d_in[15];
    a.out = (float*)d_out; a.ws = (unsigned char*)d_ws;
    void* args[] = {&a};
    hipError_t e = hipLaunchCooperativeKernel((const void*)nsa_block_fwd, dim3(grid), dim3(NWAVES * 64), args, LDS_BYTES, stream);
    if (e != hipSuccess) fprintf(stderr, "kernel_launch: cooperative launch failed: %s (grid %d)\n", hipGetErrorString(e), grid);
}
```
